# Optimizing an MI355X kernel written in HIP

```python
import jax, jax.numpy as jnp
from jax import lax
import numpy as np

D_MODEL = 1024
BATCH = 8
SEQ = 4096
DEPTH = 2

N_MEM = 256
HEAD_DIM = 64
N_GMLP_GROUPS = 6
N_FOX_HEADS = 6
N_MEM_HEADS = 4
D_GMLP = N_GMLP_GROUPS * HEAD_DIM
D_FOX = N_FOX_HEADS * HEAD_DIM
D_MEMQ = N_MEM_HEADS * HEAD_DIM
D_MIX = D_GMLP + D_FOX + D_MEMQ
D_IN = 2 * D_GMLP + 3 * D_FOX + N_FOX_HEADS + D_MEMQ
CHUNK = 128
Q_BLOCK = 128
D_FF = 4 * D_MODEL
RMS_EPS = 1e-6
NEG_INF = -1e30

kernel_name = "hybrid_gmlp_fox_memxattn_block"


def rmsnorm(x, g):
    xf = x.astype(jnp.float32)
    y = xf * lax.rsqrt(jnp.mean(jnp.square(xf), axis=-1, keepdims=True) + RMS_EPS)
    return (y * g.astype(jnp.float32)).astype(x.dtype)


def gmlp_spatial_gating(u, v, w_s, b_s, v_norm_g):
    B, S, _ = u.shape
    n_chunks = S // CHUNK
    u = jax.nn.gelu(u)
    v = jax.nn.gelu(v).reshape(B, S, N_GMLP_GROUPS, HEAD_DIM)
    v = rmsnorm(v, v_norm_g.reshape(N_GMLP_GROUPS, HEAD_DIM))
    v = v.reshape(B, n_chunks, CHUNK, N_GMLP_GROUPS, HEAD_DIM)
    w_causal = jnp.tril(w_s)
    mixed = jnp.einsum('gts,bcsgd->bctgd', w_causal, v)
    mixed = mixed + b_s.T[None, None, :, :, None].astype(mixed.dtype)
    return u * mixed.reshape(B, S, D_GMLP)


def forgetting_attention(q, k, v, log_f):
    B, S, H, dh = q.shape
    scale = dh ** -0.5
    c = jnp.cumsum(log_f, axis=1).transpose(0, 2, 1)
    q = q.transpose(0, 2, 1, 3)
    k = k.transpose(0, 2, 1, 3)
    v = v.transpose(0, 2, 1, 3)
    outs = []
    for i in range(S // Q_BLOCK):
        start, end = i * Q_BLOCK, (i + 1) * Q_BLOCK
        qb = q[:, :, start:end]
        kb = k[:, :, :end]
        vb = v[:, :, :end]
        s = jnp.einsum('bhtd,bhsd->bhts', qb, kb).astype(jnp.float32) * scale
        s = s + c[:, :, start:end, None] - c[:, :, None, :end]
        mask = jnp.arange(end)[None, :] <= jnp.arange(start, end)[:, None]
        s = jnp.where(mask, s, NEG_INF)
        p = jax.nn.softmax(s, axis=-1).astype(vb.dtype)
        outs.append(jnp.einsum('bhts,bhsd->bthd', p, vb))
    o = jnp.concatenate(outs, axis=1)
    return o.reshape(B, S, H * dh)


def memory_cross_attention(qm, mem_n, w_kv):
    B, S, _ = qm.shape
    M = mem_n.shape[1]
    km, vm = jnp.split(mem_n @ w_kv, 2, axis=-1)
    q = qm.reshape(B, S, N_MEM_HEADS, HEAD_DIM)
    km = km.reshape(B, M, N_MEM_HEADS, HEAD_DIM)
    vm = vm.reshape(B, M, N_MEM_HEADS, HEAD_DIM)
    s = jnp.einsum('bthd,bmhd->bhtm', q, km).astype(jnp.float32) * (HEAD_DIM ** -0.5)
    p = jax.nn.softmax(s, axis=-1).astype(vm.dtype)
    o = jnp.einsum('bhtm,bmhd->bthd', p, vm)
    return o.reshape(B, S, D_MEMQ)


def setup_inputs(seed: int = 0) -> dict:
    key = jax.random.key(seed)
    ks = jax.random.split(key, 17)
    f32 = jnp.float32

    def nrm(k, shape, scale):
        return jax.random.normal(k, shape, f32) * scale

    def gain(k, shape):
        return 1.0 + 0.05 * jax.random.normal(k, shape, f32)

    return {
        "x": jax.random.normal(ks[0], (BATCH, SEQ, D_MODEL), f32),
        "mem": jax.random.normal(ks[1], (BATCH, N_MEM, D_MODEL), f32),
        "norm_pre_mix": gain(ks[2], (DEPTH, D_MODEL)),
        "norm_post_mix": gain(ks[3], (DEPTH, D_MODEL)),
        "norm_pre_ffn": gain(ks[4], (DEPTH, D_MODEL)),
        "norm_post_ffn": gain(ks[5], (DEPTH, D_MODEL)),
        "norm_mem": gain(ks[6], (DEPTH, D_MODEL)),
        "w_in": nrm(ks[7], (DEPTH, D_MODEL, D_IN), D_MODEL ** -0.5),
        "b_forget": 3.0 + 0.5 * jax.random.normal(ks[8], (DEPTH, N_FOX_HEADS), f32),
        "gmlp_v_norm": gain(ks[9], (DEPTH, D_GMLP)),
        "gmlp_w_s": nrm(ks[10], (DEPTH, N_GMLP_GROUPS, CHUNK, CHUNK), CHUNK ** -0.5),
        "gmlp_b_s": 1.0 + 0.1 * jax.random.normal(ks[11], (DEPTH, N_GMLP_GROUPS, CHUNK), f32),
        "w_mem_kv": nrm(ks[12], (DEPTH, D_MODEL, 2 * D_MEMQ), D_MODEL ** -0.5),
        "w_out": nrm(ks[13], (DEPTH, D_MIX, D_MODEL), D_MIX ** -0.5),
        "w_ff1": nrm(ks[14], (DEPTH, D_MODEL, D_FF), D_MODEL ** -0.5),
        "w_ff2": nrm(ks[15], (DEPTH, D_FF, D_MODEL), D_FF ** -0.5),
    }


def reference(x, mem, norm_pre_mix, norm_post_mix, norm_pre_ffn, norm_post_ffn, norm_mem,
              w_in, b_forget, gmlp_v_norm, gmlp_w_s, gmlp_b_s, w_mem_kv, w_out, w_ff1, w_ff2):
    splits = np.cumsum([D_GMLP, D_GMLP, D_FOX, D_FOX, D_FOX, N_FOX_HEADS]).tolist()
    B, S, _ = x.shape
    for l in range(DEPTH):
        h = rmsnorm(x, norm_pre_mix[l])
        z = h @ w_in[l]
        g_u, g_v, f_q, f_k, f_v, f_gate, m_q = jnp.split(z, splits, axis=-1)

        out_a = gmlp_spatial_gating(g_u, g_v, gmlp_w_s[l], gmlp_b_s[l], gmlp_v_norm[l])

        log_f = jax.nn.log_sigmoid((f_gate + b_forget[l]).astype(jnp.float32))
        out_b = forgetting_attention(
            f_q.reshape(B, S, N_FOX_HEADS, HEAD_DIM),
            f_k.reshape(B, S, N_FOX_HEADS, HEAD_DIM),
            f_v.reshape(B, S, N_FOX_HEADS, HEAD_DIM),
            log_f)

        mem_n = rmsnorm(mem, norm_mem[l])
        out_c = memory_cross_attention(m_q, mem_n, w_mem_kv[l])

        y = jnp.concatenate([out_a, out_b, out_c], axis=-1) @ w_out[l]
        x = x + rmsnorm(y, norm_post_mix[l])

        h = rmsnorm(x, norm_pre_ffn[l])
        f = jnp.square(jax.nn.relu(h @ w_ff1[l])) @ w_ff2[l]
        x = x + rmsnorm(f, norm_post_ffn[l])
    return x
```

```cpp
#include <hip/hip_runtime.h>
#include <hip/hip_cooperative_groups.h>
#include <cstdio>
#include <cstdint>
namespace cg = cooperative_groups;
#ifndef MK_PER_PHASE
#define MK_PER_PHASE 0
#endif
namespace pg8 {
#define PG8_LAS __attribute__((address_space(3)))
typedef unsigned short bf16_t;
typedef short bf16x8 __attribute__((ext_vector_type(8)));
typedef float f32x4 __attribute__((ext_vector_type(4)));
typedef unsigned u32x4 __attribute__((ext_vector_type(4)));
constexpr int BM = 256, BK = 64, HALF = 128, HTB = HALF * BK * 2  , STAGE_BYTES = 8 * HTB, NXCD = 8, WGM = 8;

__host__ __device__ __forceinline__ int lds_byte(int r, int c) { const int st = (r >> 4) * 2 + (c >> 5), rr = r & 15, cc = c & 31, ob = rr * 64 + cc * 2; return st * 1024 + (ob ^ (((ob >> 9) & 1) << 5)); }
__host__ __device__ __forceinline__ void stage_rc(int b, int& R, int& C) { const int st = b / 1024, sb = b % 1024, swz = sb ^ (((sb >> 9) & 1) << 5); R = (st >> 1) * 16 + swz / 64; C = (st & 1) * 32 + (swz % 64) / 2; }
__host__ __device__ __forceinline__ int perm32(int rho) { const int n = rho >> 4, i = rho & 15; return 8 * (i >> 2) + 4 * n + (i & 3); }

struct Unit { int pm, pn; };
struct Gemm { const bf16_t* A; const bf16_t* Bt; int M, N, K; };

struct StaticOrder {
    int nM, nN, nwg, G, c;
    __host__ __device__ void init(int M, int N, int G_, int c_) { nM = M / BM; nN = N / BM; nwg = nM * nN; G = G_; c = c_; }
    __host__ __device__ bool next(int i, Unit& u) const {
        const long L = (long)i * G + c; if (L >= nwg) return false;
        int wgid = (int)L; { const int q = nwg / NXCD, r = nwg % NXCD, xcd = wgid % NXCD, off = wgid / NXCD; wgid = (xcd < r ? xcd * (q + 1) : r * (q + 1) + (xcd - r) * q) + off; }
        const int nig = WGM * nN, gid = wgid / nig, fm = gid * WGM, gsz = (nM - fm) < WGM ? (nM - fm) : WGM;
        u.pm = fm + ((wgid % nig) % gsz); u.pn = (wgid % nig) / gsz; return true;
    }
    __device__ __forceinline__ void a_ready(const Unit&) const {}
    __device__ __forceinline__ void done(const Unit&) const {}
};

typedef float f32x2_cv __attribute__((ext_vector_type(2))); typedef __bf16 bf16x2_cv __attribute__((ext_vector_type(2)));
__device__ __forceinline__ unsigned cvt_pk_bf16(float lo, float hi) { const f32x2_cv v = {lo, hi}; const bf16x2_cv b = __builtin_convertvector(v, bf16x2_cv); return __builtin_bit_cast(unsigned, b); }
constexpr float QC2 = 0.125f * 1.4426950408889634f;
struct EpiT {
    static constexpr bool PERM = true, AFTER_DRAIN = false;
    int MODE; bf16_t* O; int ldc; const float* rs; float* logf; const float* bfg; bf16_t* vt; unsigned* kinf;
    __device__ __forceinline__ void operator()(const f32x4 (&acc)[2][2][4][2], const Unit& u, int wr, int wc, int fr, int fq) const {
        const int row0 = u.pm * BM + wr * 64 + fr;
        const int cb = u.pn * BM + wc * 32 + 8 * fq;
        float kmx0 = 0.f, kmx1 = 0.f;
#pragma unroll
        for (int ai = 0; ai < 2; ++ai)
#pragma unroll
            for (int m = 0; m < 4; ++m) {
                const int row = row0 + ai * HALF + m * 16;
#pragma unroll
                for (int bj = 0; bj < 2; ++bj) {
                    const int c0 = cb + bj * HALF;
                    f32x4 v0 = acc[ai][bj][m][0], v1 = acc[ai][bj][m][1];
                    if (MODE == 2) {
#pragma unroll
                        for (int e = 0; e < 4; ++e) { const float a = fmaxf(v0[e], 0.f), b = fmaxf(v1[e], 0.f); v0[e] = a * a; v1[e] = b * b; }
                    }
                    if (MODE == 3) {
                        if (c0 >= 2176) {
                            if (c0 == 2176) {
                                const int bb = row >> 12, ss = row & 4095;
#define GATE_ST(h, val) do { const float y = (val) + bfg[h]; const float lf = fminf(y, 0.f) - log1pf(__expf(-fabsf(y))); logf[(size_t)(bb * 6 + (h)) * 4096 + ss] = lf; } while (0)
                                GATE_ST(0, v0[0]); GATE_ST(1, v0[1]); GATE_ST(2, v0[2]); GATE_ST(3, v0[3]); GATE_ST(4, v1[0]); GATE_ST(5, v1[1]);
#undef GATE_ST
                            }
                            continue;
                        }
                        const float sc = ((c0 >= 768 && c0 < 1152) || c0 >= 1920) ? QC2 : 1.f;
                        if (c0 >= 1152 && c0 < 1536) {
                            float mm = fmaxf(fmaxf(fabsf(v0[0]), fabsf(v0[1])), fmaxf(fabsf(v0[2]), fabsf(v0[3]))); mm = fmaxf(mm, fmaxf(fmaxf(fabsf(v1[0]), fabsf(v1[1])), fmaxf(fabsf(v1[2]), fabsf(v1[3]))));
                            if (bj == 0) kmx0 = fmaxf(kmx0, mm); else kmx1 = fmaxf(kmx1, mm);
                        }
                        v0 = v0 * sc; v1 = v1 * sc;
                    }
                    u32x4 w; w.x = cvt_pk_bf16(v0[0], v0[1]); w.y = cvt_pk_bf16(v0[2], v0[3]); w.z = cvt_pk_bf16(v1[0], v1[1]); w.w = cvt_pk_bf16(v1[2], v1[3]);
                    if (MODE == 3 && c0 >= 1536 && c0 < 1920) {
                        const int hh = (c0 - 1536) >> 6, d0 = (c0 - 1536) & 63;
                        bf16_t* vp = vt + ((size_t)((row >> 12) * 6 + hh) * 64 + d0) * 4096 + (row & 4095);
                        vp[0 * 4096] = (bf16_t)(w.x & 0xffffu); vp[1 * 4096] = (bf16_t)(w.x >> 16); vp[2 * 4096] = (bf16_t)(w.y & 0xffffu); vp[3 * 4096] = (bf16_t)(w.y >> 16);
                        vp[4 * 4096] = (bf16_t)(w.z & 0xffffu); vp[5 * 4096] = (bf16_t)(w.z >> 16); vp[6 * 4096] = (bf16_t)(w.w & 0xffffu); vp[7 * 4096] = (bf16_t)(w.w >> 16);
                        continue;
                    }
                    if (MODE == 1 && (c0 & 511) >= 256) {
                        const int ll = c0 >> 9, hd = (c0 & 511) - 256, hh = hd >> 6, d0 = hd & 63;
                        bf16_t* vp = vt + ((size_t)(((ll * 8 + (row >> 8)) * 4 + hh) * 64 + d0)) * 256 + (row & 255);
#define VM_ST(e, val) asm volatile("global_store_short %0, %1, off sc0 sc1" :: "v"(vp + (e) * 256), "v"(val) : "memory")
                        VM_ST(0, w.x & 0xffffu); VM_ST(1, w.x >> 16); VM_ST(2, w.y & 0xffffu); VM_ST(3, w.y >> 16); VM_ST(4, w.z & 0xffffu); VM_ST(5, w.z >> 16); VM_ST(6, w.w & 0xffffu); VM_ST(7, w.w >> 16);
#undef VM_ST
                        continue;
                    }
                    if (MODE == 1) { asm volatile("global_store_dwordx4 %0, %1, off sc0 sc1" :: "v"(O + (size_t)row * ldc + c0), "v"(w) : "memory"); }
                    else *(u32x4*)(O + (size_t)row * ldc + c0) = w;
                }
            }
        if (MODE == 3) {
#pragma unroll
            for (int bj = 0; bj < 2; ++bj) {
                const int c0 = cb + bj * HALF;
                if (c0 >= 1152 && c0 < 1536) {
                    float mm = bj == 0 ? kmx0 : kmx1;
#pragma unroll
                    for (int o = 1; o < 64; o <<= 1) mm = fmaxf(mm, __shfl_xor(mm, o));
                    if ((fr | fq) == 0) atomicMax(kinf + ((row0 >> 12) * 6 + ((c0 - 1152) >> 6)), __float_as_uint(mm));
                }
            }
        }
    }
};
template <class Epi, class Sched, bool ALIGN_EPI = false, bool SP2 = false>
__device__ __forceinline__ void gemm_phase(PG8_LAS unsigned char* lds, const Gemm g, const Sched& S, const Epi& E) {
    int tid = threadIdx.x; asm volatile("" : "+v"(tid));
    const int wid = __builtin_amdgcn_readfirstlane(tid >> 6), lane = tid & 63, wr = wid >> 2, wc = wid & 3, fr = lane & 15, fq = lane >> 4;
    const int K = g.K, nt = K / BK;
    unsigned voffA[2], voffB[2];
#pragma unroll
    for (int i = 0; i < 2; ++i) { int R, C; stage_rc(tid * 16 + i * 8192, R, C); const int Rb = Epi::PERM ? ((R & ~31) + perm32(R & 31)) : R;
        voffA[i] = (unsigned)(R * K + C) * 2u; voffB[i] = (unsigned)(Rb * K + C) * 2u; }
    const size_t kstep = (size_t)(BK * 2);
    const size_t hstep = (size_t)HALF * K * 2;
    const size_t tstep = 2 * hstep;
    const unsigned ldsw = (unsigned)wid * 1024u;
    const int aoff = lds_byte(wr * 64 + fr, fq * 8), boff = lds_byte(wc * 32 + fr, fq * 8);
#define PG8_SA(b, h) (((b) * 2 + (h)) * HTB)
#define PG8_SB(b, h) ((4 + (b) * 2 + (h)) * HTB)
#define PG8_STAGE(bufoff, gbase, voff) do { _Pragma("unroll") for (int _i = 0; _i < 2; ++_i) \
        __builtin_amdgcn_global_load_lds((const unsigned*)((const char*)(gbase) + (voff)[_i]), (PG8_LAS unsigned*)(lds + (bufoff) + ldsw + _i * 8192), 16, 0, 0); } while (0)
#define PG8_LDA(dst, b, h) do { _Pragma("unroll") for (int m = 0; m < 4; ++m) _Pragma("unroll") for (int k = 0; k < 2; ++k) dst[m][k] = *(const PG8_LAS bf16x8*)(lds + PG8_SA(b, h) + aoff + m * 2048 + k * 1024); } while (0)
#define PG8_LDB(dst, b, h) do { _Pragma("unroll") for (int n = 0; n < 2; ++n) _Pragma("unroll") for (int k = 0; k < 2; ++k) dst[n][k] = *(const PG8_LAS bf16x8*)(lds + PG8_SB(b, h) + boff + n * 2048 + k * 1024); } while (0)
#define PG8_MMA(ai, bj, At, Bt) do { __builtin_amdgcn_s_setprio(1); _Pragma("unroll") for (int m = 0; m < 4; ++m) _Pragma("unroll") for (int n = 0; n < 2; ++n) _Pragma("unroll") for (int k = 0; k < 2; ++k) \
        acc[ai][bj][m][n] = __builtin_amdgcn_mfma_f32_16x16x32_bf16(Bt[n][k], At[m][k], acc[ai][bj][m][n], 0, 0, 0); __builtin_amdgcn_s_setprio(0); } while (0)
#define PG8_WAIT_V(n) asm volatile("s_waitcnt vmcnt(" #n ")" ::: "memory")
#define PG8_WAIT_L(n) asm volatile("s_waitcnt lgkmcnt(" #n ")" ::: "memory")
#define PG8_BAR __builtin_amdgcn_s_barrier()
#define PG8_SCHED __builtin_amdgcn_sched_barrier(0)
    Unit cur, nxt; int ui = 0;
    if (!S.next(0, cur)) return;
    f32x4 acc[2][2][4][2];
#pragma unroll
    for (int a = 0; a < 2; ++a)
#pragma unroll
        for (int b = 0; b < 2; ++b)
#pragma unroll
            for (int m = 0; m < 4; ++m)
#pragma unroll
                for (int n = 0; n < 2; ++n) acc[a][b][m][n] = (f32x4){0.f, 0.f, 0.f, 0.f};
    bf16x8 At[4][2], B0[2][2], B1[2][2];
    const char* cA = (const char*)g.A + (size_t)cur.pm * tstep; const char* cB = (const char*)g.Bt + (size_t)cur.pn * tstep;
    S.a_ready(cur);
    if constexpr (SP2) {
        PG8_STAGE(PG8_SB(0, 0), cB, voffB); PG8_STAGE(PG8_SB(0, 1), cB + hstep, voffB); PG8_STAGE(PG8_SA(0, 0), cA, voffA); PG8_STAGE(PG8_SA(0, 1), cA + hstep, voffA);
        if (wr == 1) PG8_BAR;
        PG8_WAIT_V(2); PG8_BAR;
        PG8_STAGE(PG8_SB(1, 0), cB + kstep, voffB); PG8_STAGE(PG8_SA(1, 0), cA + kstep, voffA); PG8_STAGE(PG8_SB(1, 1), cB + hstep + kstep, voffB);
        PG8_WAIT_V(6); PG8_BAR;
    } else {
        PG8_STAGE(PG8_SB(0, 0), cB, voffB); PG8_STAGE(PG8_SA(0, 0), cA, voffA); PG8_STAGE(PG8_SB(0, 1), cB + hstep, voffB); PG8_STAGE(PG8_SA(0, 1), cA + hstep, voffA);
        if (wr == 1) PG8_BAR;
        PG8_WAIT_V(4); PG8_BAR;
        PG8_STAGE(PG8_SB(1, 0), cB + kstep, voffB); PG8_STAGE(PG8_SA(1, 0), cA + kstep, voffA); PG8_STAGE(PG8_SB(1, 1), cB + hstep + kstep, voffB);
        PG8_WAIT_V(6); PG8_BAR;
    }
    for (;;) {
        const bool has_next = S.next(ui + 1, nxt);
        const char* nA = has_next ? (const char*)g.A + (size_t)nxt.pm * tstep : cA; const char* nB = has_next ? (const char*)g.Bt + (size_t)nxt.pn * tstep : cB;
        for (int t = 0; t < nt; t += 2) {
            const bool last = (t == nt - 2);
            const char* a1 = cA + (size_t)(t + 1) * kstep;
            const char* a2 = last ? nA : cA + (size_t)(t + 2) * kstep; const char* b2 = last ? nB : cB + (size_t)(t + 2) * kstep;
            const char* a3 = a2 + kstep; const char* b3 = b2 + kstep;
            if (last && has_next) S.a_ready(nxt);
            if constexpr (SP2) {
            PG8_LDB(B0, 0, 0); PG8_LDB(B1, 0, 1); PG8_SCHED; PG8_LDA(At, 0, 0); PG8_STAGE(PG8_SA(1, 1), a1 + hstep, voffA);
            PG8_WAIT_V(8); PG8_WAIT_L(0); PG8_BAR; PG8_MMA(0, 0, At, B0); PG8_MMA(0, 1, At, B1); PG8_BAR; PG8_SCHED;
            PG8_LDA(At, 0, 1); PG8_STAGE(PG8_SB(0, 0), b2, voffB); PG8_STAGE(PG8_SB(0, 1), b2 + hstep, voffB); PG8_STAGE(PG8_SA(0, 0), a2, voffA);
            PG8_WAIT_V(8); PG8_WAIT_L(0); PG8_BAR; PG8_MMA(1, 0, At, B0); PG8_MMA(1, 1, At, B1); PG8_BAR; PG8_SCHED;
            PG8_LDB(B0, 1, 0); PG8_LDB(B1, 1, 1); PG8_SCHED; PG8_LDA(At, 1, 0); PG8_STAGE(PG8_SA(0, 1), a2 + hstep, voffA);
            PG8_WAIT_V(8); PG8_WAIT_L(0); PG8_BAR; PG8_MMA(0, 0, At, B0); PG8_MMA(0, 1, At, B1); PG8_BAR; PG8_SCHED;
            PG8_LDA(At, 1, 1); PG8_STAGE(PG8_SB(1, 0), b3, voffB); PG8_STAGE(PG8_SB(1, 1), b3 + hstep, voffB); PG8_STAGE(PG8_SA(1, 0), a3, voffA);
            PG8_WAIT_V(8); PG8_WAIT_L(0); PG8_BAR; PG8_MMA(1, 0, At, B0); PG8_MMA(1, 1, At, B1); PG8_BAR; PG8_SCHED;
            } else {
            PG8_LDB(B0, 0, 0); PG8_SCHED; PG8_LDA(At, 0, 0); PG8_STAGE(PG8_SA(1, 1), a1 + hstep, voffA);
            PG8_WAIT_L(8); PG8_BAR; PG8_WAIT_L(0); PG8_MMA(0, 0, At, B0); PG8_BAR; PG8_SCHED;
            PG8_LDB(B1, 0, 1); PG8_STAGE(PG8_SB(0, 0), b2, voffB);
            PG8_BAR; PG8_WAIT_L(0); PG8_MMA(0, 1, At, B1); PG8_BAR;
            PG8_LDA(At, 0, 1); PG8_STAGE(PG8_SA(0, 0), a2, voffA);
            PG8_BAR; PG8_WAIT_L(0); PG8_MMA(1, 0, At, B0); PG8_BAR; PG8_SCHED;
            PG8_STAGE(PG8_SB(0, 1), b2 + hstep, voffB);
            PG8_WAIT_V(6); PG8_BAR; PG8_MMA(1, 1, At, B1); PG8_BAR;
            PG8_LDB(B0, 1, 0); PG8_SCHED; PG8_LDA(At, 1, 0); PG8_STAGE(PG8_SA(0, 1), a2 + hstep, voffA);
            PG8_WAIT_L(8); PG8_BAR; PG8_WAIT_L(0); PG8_MMA(0, 0, At, B0); PG8_BAR; PG8_SCHED;
            PG8_LDB(B1, 1, 1); PG8_STAGE(PG8_SB(1, 0), b3, voffB);
            PG8_BAR; PG8_WAIT_L(0); PG8_MMA(0, 1, At, B1); PG8_BAR;
            PG8_LDA(At, 1, 1); PG8_STAGE(PG8_SA(1, 0), a3, voffA);
            PG8_BAR; PG8_WAIT_L(0); PG8_MMA(1, 0, At, B0); PG8_BAR; PG8_SCHED;
            PG8_STAGE(PG8_SB(1, 1), b3 + hstep, voffB);
            PG8_WAIT_V(6); PG8_BAR; PG8_MMA(1, 1, At, B1); PG8_BAR;
            }
        }
        if constexpr (ALIGN_EPI) { if (wr == 0) PG8_BAR; }
        if constexpr (!Epi::AFTER_DRAIN) { E(acc, cur, wr, wc, fr, fq); S.done(cur); }
        if (!has_next) break;
#pragma unroll
        for (int a = 0; a < 2; ++a)
#pragma unroll
            for (int b = 0; b < 2; ++b)
#pragma unroll
                for (int m = 0; m < 4; ++m)
#pragma unroll
                    for (int n = 0; n < 2; ++n) acc[a][b][m][n] = (f32x4){0.f, 0.f, 0.f, 0.f};
        cur = nxt; cA = nA; cB = nB; ++ui;
        if constexpr (ALIGN_EPI) { if (wr == 1) PG8_BAR; }
    }
    PG8_WAIT_V(0);
    if constexpr (!ALIGN_EPI) { if (wr == 0) PG8_BAR; }
    PG8_BAR;
    if constexpr (Epi::AFTER_DRAIN) { E.fused(acc, cur, wr, wc, fr, fq, lds, wid, lane); S.done(cur); }
#undef PG8_SA
#undef PG8_SB
#undef PG8_STAGE
#undef PG8_LDA
#undef PG8_LDB
#undef PG8_MMA
#undef PG8_WAIT_V
#undef PG8_WAIT_L
#undef PG8_BAR
#undef PG8_SCHED
}
}
constexpr int NWAVES = 8, NTHREADS = 512;
constexpr int BATCH = 8, SEQ = 4096, DM = 1024, DEPTH = 2, NMEM = 256, HD = 64;
constexpr int M = BATCH * SEQ;
constexpr int MMEM = BATCH * NMEM;
constexpr int D_IN = 2182, NIN = 2304;
constexpr int ZP = 2176;
constexpr int DFF = 4096;
constexpr float RMS_EPS = 1e-6f;
constexpr float LOG2E = 1.4426950408889634f;

constexpr size_t MiB = 1u << 20;
constexpr size_t WS_CTL = 0;
constexpr size_t WS_WIN = 1 * MiB;
constexpr size_t WS_WOUT = 10 * MiB;
constexpr size_t WS_W1 = 14 * MiB;
constexpr size_t WS_W2 = 30 * MiB;
constexpr size_t WS_WKV = 46 * MiB;
constexpr size_t WS_WS = 48 * MiB;
constexpr size_t WS_RSTD = 49 * MiB;
constexpr size_t WS_CL = 50 * MiB;
constexpr size_t WS_MEMB = 52 * MiB;
constexpr size_t WS_KVM = 56 * MiB;
constexpr size_t WS_XB = 64 * MiB;
constexpr size_t WS_Y = 128 * MiB;
constexpr size_t WS_HID = 192 * MiB;
constexpr size_t WS_Z = 192 * MiB;
constexpr size_t WS_MIX = 328 * MiB;
constexpr size_t WS_VT = 392 * MiB;
constexpr size_t WS_VMT = 60 * MiB;
constexpr size_t WS_END = 448 * MiB;

constexpr int LDS_BYTES = 131072 + 1024;

#define GAS __attribute__((address_space(1)))
#define LAS __attribute__((address_space(3)))
typedef unsigned short bf16;
typedef unsigned u32x4 __attribute__((ext_vector_type(4)));
typedef unsigned u32x2 __attribute__((ext_vector_type(2)));
typedef float f32x4 __attribute__((ext_vector_type(4)));
typedef float f32x16 __attribute__((ext_vector_type(16)));
typedef float f32x2 __attribute__((ext_vector_type(2)));
typedef short bf16x8 __attribute__((ext_vector_type(8)));
typedef short s16x4 __attribute__((ext_vector_type(4)));

#define LDG(T, p) (*(const GAS T*)(p))
#define STG(T, p, v) (*(GAS T*)(p) = (v))
__device__ __forceinline__ unsigned pk2(float lo, float hi) { return pg8::cvt_pk_bf16(lo, hi); }
__device__ __forceinline__ float bf_lo(unsigned u) { return __uint_as_float(u << 16); }
__device__ __forceinline__ float bf_hi(unsigned u) { return __uint_as_float(u & 0xffff0000u); }
__device__ __forceinline__ float wave_sum(float v) {
#pragma unroll
    for (int o = 1; o < 64; o <<= 1) v += __shfl_xor(v, o);
    return v;
}
__device__ __forceinline__ float gelu_tanh(float x) {
    const float t = x + 0.044715f * x * x * x;
    const float e = __builtin_amdgcn_exp2f(-2.3022082f * t);
    return x * __builtin_amdgcn_rcpf(1.0f + e);
}
__device__ __forceinline__ int crow(int r, int hi) { return (r & 3) + 8 * (r >> 2) + 4 * hi; }

#define XB_TMO      128
#define XB_XCNT(j)  (256  + 64 * (j))
#define XB_XSUB(j)  (1280 + 64 * (j))
#define XB_XGEN(j)  (2304 + 64 * (j))
#define XB_TOP      3328
#define XB_TOPGEN   3392
#define XCD_BAR_WORDS 3456
#define XB_SPIN_CAP (1u << 18)

__device__ __forceinline__ unsigned xb_ld(unsigned* p)              { return __hip_atomic_load(p, __ATOMIC_RELAXED, __HIP_MEMORY_SCOPE_AGENT); }
__device__ __forceinline__ unsigned xb_add(unsigned* p, unsigned v) { return __hip_atomic_fetch_add(p, v, __ATOMIC_RELAXED, __HIP_MEMORY_SCOPE_AGENT); }
__device__ __forceinline__ unsigned xb_xcc_id() { return (unsigned)__builtin_amdgcn_s_getreg((3 << 11) | 20) & 0xFu; }
#define XB_SPIN(cond, bar) do { unsigned _sp = 0; while (cond) { __builtin_amdgcn_s_sleep(1); \
    if ((++_sp & 255u) == 0u) { if (xb_ld(&(bar)[XB_TMO])) break; if (_sp > XB_SPIN_CAP) { atomicAdd(&(bar)[XB_TMO], 1u); break; } } } } while (0)

struct XcdBarrier {
    unsigned* bar; unsigned x;
    volatile LAS unsigned* st;
};

__device__ __forceinline__ XcdBarrier xcd_barrier_post(unsigned* bar, volatile LAS unsigned* st) {
    XcdBarrier b; b.bar = bar; b.x = xb_xcc_id(); b.st = st;
    if (threadIdx.x == 0) (void)xb_add(&bar[XB_XCNT(b.x)], 1u);
    return b;
}
__device__ __forceinline__ void xcd_barrier_complete(unsigned* bar, unsigned x, unsigned& nloc, unsigned& nx) {
    const unsigned G = gridDim.x * gridDim.y * gridDim.z;
    unsigned sum, cnt, mine, sp = 0u;
    for (;;) {
        sum = 0u; cnt = 0u; mine = 0u;
#pragma unroll
        for (unsigned j = 0; j < 16; ++j) { const unsigned c = xb_ld(&bar[XB_XCNT(j)]); sum += c; cnt += (c > 0u) ? 1u : 0u; mine = (j == x) ? c : mine; }
        if (sum == G) break;
        __builtin_amdgcn_s_sleep(1);
        if ((++sp & 255u) == 0u) { if (xb_ld(&bar[XB_TMO])) break; if (sp > XB_SPIN_CAP) { atomicAdd(&bar[XB_TMO], 1u); break; } }
    }
    nloc = mine > 0u ? mine : 1u; nx = cnt > 0u ? cnt : 1u;
}

__device__ __forceinline__ void xcd_barrier(const XcdBarrier& b) {
    asm volatile("s_waitcnt vmcnt(0)" ::: "memory");
    __syncthreads();
    if (threadIdx.x == 0) {
        unsigned* bar = b.bar;
        __builtin_amdgcn_s_waitcnt(0);
        unsigned nloc = b.st[0], nx = b.st[1];
        if (nloc == 0u) { xcd_barrier_complete(bar, b.x, nloc, nx); b.st[0] = nloc; b.st[1] = nx; }
        const unsigned old = xb_add(&bar[XB_XSUB(b.x)], 1u);
        const unsigned gen = old / nloc;
        if (old + 1u == (gen + 1u) * nloc) {
            __builtin_amdgcn_fence(__ATOMIC_RELEASE, "agent");
            asm volatile("s_waitcnt vmcnt(0)" ::: "memory");
            const unsigned og = xb_add(&bar[XB_TOP], 1u);
            const unsigned tg = og / nx;
            if (og + 1u == (tg + 1u) * nx) xb_add(&bar[XB_TOPGEN], 1u);
            else XB_SPIN(xb_ld(&bar[XB_TOPGEN]) == tg, bar);
            __builtin_amdgcn_fence(__ATOMIC_ACQUIRE, "agent");
            xb_add(&bar[XB_XGEN(b.x)], 1u);
            asm volatile("s_waitcnt vmcnt(0)" ::: "memory");
        } else {
            XB_SPIN(xb_ld(&bar[XB_XGEN(b.x)]) == gen, bar);
            __builtin_amdgcn_fence(__ATOMIC_ACQUIRE, "agent");
            asm volatile("s_waitcnt vmcnt(0)" ::: "memory");
        }
    }
    __syncthreads();
}

struct Args {
    const float* in[16];
    float* out; unsigned char* ws;
    int ph_lo, ph_hi;
};

struct TItem { const float* W; int K, N, nblk; bf16* WT; const float* gain; int mode, item; };
__device__ __forceinline__ TItem prep_mat(const Args& a, unsigned char* ws, int l, int which, int r) {
    if (which == 0) return TItem{a.in[7] + (size_t)l * DM * D_IN, DM, D_IN, 72, (bf16*)(ws + WS_WIN) + (size_t)l * NIN * DM, a.in[2] + l * DM, 1, r};
    if (which == 1) return TItem{a.in[13] + (size_t)l * DM * DM, DM, DM, 32, (bf16*)(ws + WS_WOUT) + (size_t)l * DM * DM, nullptr, 0, r};
    if (which == 2) return TItem{a.in[14] + (size_t)l * DM * DFF, DM, DFF, 128, (bf16*)(ws + WS_W1) + (size_t)l * DFF * DM, a.in[4] + l * DM, 0, r};
    if (which == 3) return TItem{a.in[15] + (size_t)l * DFF * DM, DFF, DM, 32, (bf16*)(ws + WS_W2) + (size_t)l * DM * DFF, nullptr, 0, r};
    return TItem{a.in[12] + (size_t)l * DM * 512, DM, 512, 16, (bf16*)(ws + WS_WKV) + (size_t)l * 512 * DM, a.in[6] + l * DM, 0, r};
}
constexpr int I_IN = 16 * 72, I_OUT = 16 * 32, I_1 = 16 * 128, I_2 = 64 * 32, I_KV = 16 * 16;
constexpr int NITEMS_A = I_IN + 2 * I_KV;
constexpr int NITEMS_B = (I_OUT + I_1 + I_2) + I_IN;
constexpr int NITEMS_C = (I_OUT + I_1 + I_2);
__device__ __forceinline__ TItem prep_item(const Args& a, unsigned char* ws, int set, int j) {
    if (set == 0) { if (j < I_IN) return prep_mat(a, ws, 0, 0, j); j -= I_IN; if (j < I_KV) return prep_mat(a, ws, 0, 4, j); return prep_mat(a, ws, 1, 4, j - I_KV); }
    const int l = (set == 1) ? 0 : 1;
    if (j < I_OUT) return prep_mat(a, ws, l, 1, j); j -= I_OUT;
    if (j < I_1) return prep_mat(a, ws, l, 2, j); j -= I_1;
    if (j < I_2) return prep_mat(a, ws, l, 3, j); j -= I_2;
    return prep_mat(a, ws, 1, 0, j);
}
#define TITEM_LOAD(T, R) do { const int kb_ = (T).item / (T).nblk, nb_ = (T).item % (T).nblk, k0_ = 64 * kb_, n_ = 32 * nb_ + (lane & 31); int src_ = n_; float vm_ = 1.f; \
        if ((T).mode == 1) { src_ = (n_ < 1920) ? n_ : (n_ < 2176) ? n_ + 6 : (n_ < 2182) ? n_ - 256 : 0; vm_ = (n_ < 2182) ? 1.f : 0.f; } \
        const float* wp_ = (T).W + (size_t)(k0_ + (lane >> 5)) * (T).N + src_; const size_t rs_ = (size_t)2 * (T).N; \
        _Pragma("unroll") for (int i_ = 0; i_ < 32; ++i_) R[i_] = LDG(float, wp_ + i_ * rs_); \
        if ((T).mode == 1) { _Pragma("unroll") for (int i_ = 0; i_ < 32; ++i_) R[i_] *= vm_; } } while (0)
#define TITEM_FINISH(T, R) do { const int kb_ = (T).item / (T).nblk, nb_ = (T).item % (T).nblk, k0_ = 64 * kb_, n0_ = 32 * nb_; const int c_ = lane & 7; \
        f32x4 g0_ = (f32x4){1.f, 1.f, 1.f, 1.f}, g1_ = g0_; if ((T).gain) { g0_ = LDG(f32x4, (T).gain + k0_ + 8 * c_); g1_ = LDG(f32x4, (T).gain + k0_ + 8 * c_ + 4); } \
        _Pragma("unroll") for (int i_ = 0; i_ < 32; ++i_) scr[(2 * i_ + (lane >> 5)) * 33 + (lane & 31)] = R[i_]; \
        asm volatile("s_waitcnt lgkmcnt(0)" ::: "memory"); \
        _Pragma("unroll") for (int j_ = 0; j_ < 4; ++j_) { const int nn_ = (lane >> 3) + 8 * j_; const LAS float* s_ = scr + (8 * c_) * 33 + nn_; \
            u32x4 o_; o_.x = pk2(s_[0 * 33] * g0_[0], s_[1 * 33] * g0_[1]); o_.y = pk2(s_[2 * 33] * g0_[2], s_[3 * 33] * g0_[3]); o_.z = pk2(s_[4 * 33] * g1_[0], s_[5 * 33] * g1_[1]); o_.w = pk2(s_[6 * 33] * g1_[2], s_[7 * 33] * g1_[3]); \
            STG(u32x4, (T).WT + (size_t)(n0_ + nn_) * (T).K + k0_ + 8 * c_, o_); } \
        asm volatile("s_waitcnt lgkmcnt(0)" ::: "memory"); } while (0)
__device__ __forceinline__ void run_transposes(const Args& a, unsigned char* ws, LAS float* scr, int set, int nitems, int w, int nw, int lane) {
    float r[32], rn[32]; int it = w;
    if (it < nitems) { const TItem T = prep_item(a, ws, set, it); TITEM_LOAD(T, r); }
    for (; it < nitems; it += nw) {
        const int itn = it + nw;
        if (itn < nitems) { const TItem Tn = prep_item(a, ws, set, itn); TITEM_LOAD(Tn, rn); }
        const TItem T = prep_item(a, ws, set, it);
        TITEM_FINISH(T, r);
#pragma unroll
        for (int i = 0; i < 32; ++i) r[i] = rn[i];
    }
}
__device__ __forceinline__ void phase_prep(const Args& a, unsigned char* ws, LAS unsigned char* lds, int tid, int lane, int wave) {
    const int G = gridDim.x, gw = blockIdx.x * NWAVES + wave, NGW = G * NWAVES;
    if (blockIdx.x == 0 && tid < 256) ((unsigned*)(ws + WS_CTL))[tid] = 0u;
    LAS float* scr = (LAS float*)(lds + wave * 16384);
    {
        f32x4 v[4], vn[4]; int m = gw;
#define PREP_ROWPTR(mm) ((mm) < M ? a.in[0] + (size_t)(mm) * DM : a.in[1] + (size_t)((mm) - M) * DM)
        if (m < M + MMEM) { const f32x4* xr = (const f32x4*)PREP_ROWPTR(m) + lane;
#pragma unroll
            for (int j = 0; j < 4; ++j) v[j] = LDG(f32x4, xr + 64 * j); }
        for (; m < M + MMEM; m += NGW) {
            const int mn = m + NGW;
            if (mn < M + MMEM) { const f32x4* xr = (const f32x4*)PREP_ROWPTR(mn) + lane;
#pragma unroll
                for (int j = 0; j < 4; ++j) vn[j] = LDG(f32x4, xr + 64 * j); }
            float s = 0.f;
#pragma unroll
            for (int j = 0; j < 4; ++j) s += (v[j].x * v[j].x + v[j].y * v[j].y) + (v[j].z * v[j].z + v[j].w * v[j].w);
            const float ms = wave_sum(s) * (1.0f / 1024.0f) + RMS_EPS, rn = 1.0f / sqrtf(ms);
            if (m < M && lane == 0) STG(float, (float*)(ws + WS_RSTD) + m, sqrtf(ms));
            u32x2* o8 = (u32x2*)(m < M ? (bf16*)(ws + WS_XB) + (size_t)m * DM : (bf16*)(ws + WS_MEMB) + (size_t)(m - M) * DM) + lane;
#pragma unroll
            for (int j = 0; j < 4; ++j) { u32x2 w; w.x = pk2(v[j].x * rn, v[j].y * rn); w.y = pk2(v[j].z * rn, v[j].w * rn); STG(u32x2, o8 + 64 * j, w); }
#pragma unroll
            for (int j = 0; j < 4; ++j) v[j] = vn[j];
        }
#undef PREP_ROWPTR
    }
    run_transposes(a, ws, scr, 0, NITEMS_A, gw, NGW, lane);
    { const float* wsrc = a.in[10]; bf16* wd = (bf16*)(ws + WS_WS);
      for (int i = blockIdx.x * NTHREADS + tid; i < DEPTH * 6 * 128 * 128; i += G * NTHREADS) { const int s = i & 127, t = (i >> 7) & 127; const float v = (s <= t) ? wsrc[i] : 0.f; wd[i] = (bf16)(pk2(v, 0.f) & 0xffffu); } }
}
#undef TITEM_LOAD
#undef TITEM_FINISH

template <bool SRC_F32, bool DST_F32>
__device__ __forceinline__ void phase_rows(const float* XF, float* OF, const bf16* Y, const float* g, bf16* XB, float* RINV, int lane, int wave) {
    const int gw = blockIdx.x * NWAVES + wave, NGW = gridDim.x * NWAVES;
    f32x4 gv[4];
#pragma unroll
    for (int j = 0; j < 4; ++j) gv[j] = LDG(f32x4, (const f32x4*)g + lane + 64 * j);
    u32x2 yw[4], ywn[4], xw[4], xwn[4]; f32x4 xv[4], xvn[4]; float ri = 1.f, rin = 1.f;
    int m = gw;
#define ROWS_LOAD(mm, YW, XV, XW, RI) do { _Pragma("unroll") for (int j = 0; j < 4; ++j) { YW[j] = LDG(u32x2, (const u32x2*)(Y + (size_t)(mm) * DM) + lane + 64 * j); \
        if (SRC_F32) XV[j] = LDG(f32x4, (const f32x4*)(XF + (size_t)(mm) * DM) + lane + 64 * j); else XW[j] = LDG(u32x2, (const u32x2*)(XB + (size_t)(mm) * DM) + lane + 64 * j); } \
        if (!SRC_F32) RI = LDG(float, RINV + (mm)); } while (0)
    if (m < M) ROWS_LOAD(m, yw, xv, xw, ri);
    for (; m < M; m += NGW) {
        const int mn = m + NGW;
        if (mn < M) ROWS_LOAD(mn, ywn, xvn, xwn, rin);
        f32x4 yv[4]; float s = 0.f;
#pragma unroll
        for (int j = 0; j < 4; ++j) { const u32x2 w = yw[j]; yv[j] = (f32x4){bf_lo(w.x), bf_hi(w.x), bf_lo(w.y), bf_hi(w.y)};
            s += (yv[j].x * yv[j].x + yv[j].y * yv[j].y) + (yv[j].z * yv[j].z + yv[j].w * yv[j].w);
            if (!SRC_F32) { const u32x2 xx = xw[j]; xv[j] = (f32x4){bf_lo(xx.x), bf_hi(xx.x), bf_lo(xx.y), bf_hi(xx.y)} * ri; } }
        const float ry = 1.0f / sqrtf(wave_sum(s) * (1.0f / 1024.0f) + RMS_EPS);
        f32x4 xn[4]; float s2 = 0.f;
#pragma unroll
        for (int j = 0; j < 4; ++j) { xn[j] = xv[j] + yv[j] * ry * gv[j]; s2 += (xn[j].x * xn[j].x + xn[j].y * xn[j].y) + (xn[j].z * xn[j].z + xn[j].w * xn[j].w); }
        if (DST_F32) {
            f32x4* xo = (f32x4*)(OF + (size_t)m * DM) + lane;
#pragma unroll
            for (int j = 0; j < 4; ++j) STG(f32x4, xo + 64 * j, xn[j]);
        } else {
            const float ms = wave_sum(s2) * (1.0f / 1024.0f) + RMS_EPS, rn = 1.0f / sqrtf(ms);
            u32x2* bo = (u32x2*)(XB + (size_t)m * DM) + lane;
#pragma unroll
            for (int j = 0; j < 4; ++j) { u32x2 w; w.x = pk2(xn[j].x * rn, xn[j].y * rn); w.y = pk2(xn[j].z * rn, xn[j].w * rn); STG(u32x2, bo + 64 * j, w); }
            if (lane == 0) STG(float, RINV + m, sqrtf(ms));
        }
#pragma unroll
        for (int j = 0; j < 4; ++j) { yw[j] = ywn[j]; xv[j] = xvn[j]; xw[j] = xwn[j]; }
        ri = rin;
    }
#undef ROWS_LOAD
}

__device__ __forceinline__ void phase_cumsum(float* cl, LAS unsigned char* lds, int tid, int lane, int wave) {
    LAS float* wsum = (LAS float*)(lds);
    for (int bh = blockIdx.x; bh < BATCH * 6; bh += gridDim.x) {
        float* p = cl + (size_t)bh * SEQ + tid * 8;
        f32x4 a = ((const f32x4*)p)[0], b = ((const f32x4*)p)[1];
        a.y += a.x; a.z += a.y; a.w += a.z; b.x += a.w; b.y += b.x; b.z += b.y; b.w += b.z;
        const float tot = b.w; float sc = tot;
#pragma unroll
        for (int o = 1; o < 64; o <<= 1) { const float t = __shfl_up(sc, o); if (lane >= o) sc += t; }
        if (lane == 63) wsum[wave] = sc;
        __syncthreads();
        float off = sc - tot;
        for (int w = 0; w < wave; ++w) off += wsum[w];
        a = (a + off) * LOG2E; b = (b + off) * LOG2E;
        ((f32x4*)p)[0] = a; ((f32x4*)p)[1] = b;
        __syncthreads();
    }
}
constexpr int A_KB = 64 * 144, A_VOFF = 2 * A_KB, A_VROW = 136, A_VB = 64 * A_VROW, A_COFF = A_VOFF + 2 * A_VB;
constexpr float NEG_BIG = -1e30f;
__device__ __forceinline__ u32x4 ld16_coh(const void* p) { GAS unsigned* q = (GAS unsigned*)p; u32x4 r;
    r.x = __hip_atomic_load(q + 0, __ATOMIC_RELAXED, __HIP_MEMORY_SCOPE_AGENT); r.y = __hip_atomic_load(q + 1, __ATOMIC_RELAXED, __HIP_MEMORY_SCOPE_AGENT);
    r.z = __hip_atomic_load(q + 2, __ATOMIC_RELAXED, __HIP_MEMORY_SCOPE_AGENT); r.w = __hip_atomic_load(q + 3, __ATOMIC_RELAXED, __HIP_MEMORY_SCOPE_AGENT); return r; }
template <bool FOX>
__device__ __forceinline__ void attn_unit(LAS unsigned char* lds, const bf16* Qp, int qpitch, const bf16* Kp, int kvpitch, const bf16* Vp, int vpitch,
                                          const float* clq, const float* clk, bf16* Op, int opitch, int q0, int NT, float kinf, int tid, int lane, int wid) {
    const int r32 = lane & 31, hi = lane >> 5;
    bf16x8 qr[4];
    { const bf16* qrow = Qp + (size_t)(wid * 32 + r32) * qpitch + hi * 8;
#pragma unroll
      for (int ds = 0; ds < 4; ++ds) qr[ds] = LDG(bf16x8, qrow + ds * 16); }
    float clq_l = 0.f; if (FOX) clq_l = LDG(float, clq + wid * 32 + r32);
    const int skv = tid >> 3, sdc = tid & 7;
    const bf16* kg = Kp + (size_t)skv * kvpitch + sdc * 8;
    const bf16* vg = Vp + (size_t)skv * vpitch + sdc * 8;
    u32x4 kreg, vreg, kreg2, vreg2; float creg = 0.f, creg2 = 0.f;
#define A_LOAD_TILE(tt, KR, VR, CR) do { const size_t off_ = (size_t)(tt) * 64 * kvpitch; const int voff_ = (tt) * 64; \
        if (FOX) { KR = LDG(u32x4, kg + off_); VR = LDG(u32x4, vg + voff_); if (tid < 64) CR = LDG(float, clk + (tt) * 64 + tid); } else { KR = ld16_coh(kg + off_); VR = ld16_coh(vg + voff_); } } while (0)
    A_LOAD_TILE(NT - 1, kreg, vreg, creg);
#define A_WRITE_STAGE(b) do { \
        *(LAS u32x4*)(lds + (b) * A_KB + skv * 144 + sdc * 16) = kreg; \
        *(LAS u32x2*)(lds + A_VOFF + (b) * A_VB + skv * A_VROW + sdc * 16) = (u32x2){vreg.x, vreg.y}; *(LAS u32x2*)(lds + A_VOFF + (b) * A_VB + skv * A_VROW + sdc * 16 + 8) = (u32x2){vreg.z, vreg.w}; \
        if (FOX && tid < 64) *(LAS float*)(lds + A_COFF + (b) * 256 + tid * 4) = -creg; } while (0)
    A_WRITE_STAGE(0);
    if (NT > 1) A_LOAD_TILE(NT - 2, kreg, vreg, creg);
    __syncthreads();
    float qb = 0.f, wb = 0.f;
    if (FOX) {
        float l1 = 0.f;
#pragma unroll
        for (int ds = 0; ds < 4; ++ds)
#pragma unroll
            for (int e = 0; e < 8; ++e) l1 += fabsf(__uint_as_float((unsigned)(unsigned short)qr[ds][e] << 16));
        l1 += __shfl_xor(l1, 32);
        qb = l1 * kinf * 1.02f;
    }
    float cm = clq_l, lrun = 0.f; f32x16 o0, o1;
#pragma unroll
    for (int r = 0; r < 16; ++r) { o0[r] = 0.f; o1[r] = 0.f; }
    const int qmin_w = q0 + wid * 32, qmax_w = qmin_w + 31, qme = qmin_w + r32;
#define A_WAVE_BOUND() do { float t_ = qb + cm; _Pragma("unroll") for (int o_ = 1; o_ < 64; o_ <<= 1) t_ = fmaxf(t_, __shfl_xor(t_, o_)); wb = t_; } while (0)
    if (FOX) A_WAVE_BOUND();
    for (int it = 0; it < NT; ++it) {
        const int t = NT - 1 - it, b = it & 1;
        if (it + 2 < NT) A_LOAD_TILE(t - 2, kreg2, vreg2, creg2);
        const bool active = !FOX || (64 * t <= qmax_w);
        if (active) {
            f32x16 p0, p1;
            if (FOX) {
                const f32x2 cm2 = (f32x2){cm, cm};
#pragma unroll
                for (int g = 0; g < 4; ++g) {
                    const f32x4 c0 = *(const LAS f32x4*)(lds + A_COFF + b * 256 + (8 * g + 4 * hi) * 4);
                    const f32x4 c1 = *(const LAS f32x4*)(lds + A_COFF + b * 256 + (32 + 8 * g + 4 * hi) * 4);
                    const f32x2 a0 = cm2 + (f32x2){c0[0], c0[1]}, a1 = cm2 + (f32x2){c0[2], c0[3]}, b0 = cm2 + (f32x2){c1[0], c1[1]}, b1 = cm2 + (f32x2){c1[2], c1[3]};
                    p0[4 * g] = a0.x; p0[4 * g + 1] = a0.y; p0[4 * g + 2] = a1.x; p0[4 * g + 3] = a1.y;
                    p1[4 * g] = b0.x; p1[4 * g + 1] = b0.y; p1[4 * g + 2] = b1.x; p1[4 * g + 3] = b1.y;
                }
            } else {
#pragma unroll
                for (int r = 0; r < 16; ++r) { p0[r] = cm; p1[r] = cm; }
            }
            const LAS unsigned char* kb = lds + b * A_KB + r32 * 144 + hi * 16;
#pragma unroll
            for (int ds = 0; ds < 4; ++ds) {
                const bf16x8 a0 = *(const LAS bf16x8*)(kb + ds * 32);
                const bf16x8 a1 = *(const LAS bf16x8*)(kb + 32 * 144 + ds * 32);
                p0 = __builtin_amdgcn_mfma_f32_32x32x16_bf16(a0, qr[ds], p0, 0, 0, 0);
                p1 = __builtin_amdgcn_mfma_f32_32x32x16_bf16(a1, qr[ds], p1, 0, 0, 0);
            }
            if (FOX && (64 * t + 63 > qmin_w)) {
                const int kv0 = 64 * t + 4 * hi;
#pragma unroll
                for (int r = 0; r < 16; ++r) { const int kv = kv0 + (r & 3) + 8 * (r >> 2); if (kv > qme) p0[r] = NEG_BIG; if (kv + 32 > qme) p1[r] = NEG_BIG; }
            }
#define MX3(a, b, c) __builtin_fmaxf(__builtin_fmaxf((a), (b)), (c))
            float ma = MX3(p0[0], p0[1], p1[0]), mb = MX3(p0[2], p0[3], p1[1]); ma = MX3(ma, p1[2], p1[3]);
#pragma unroll
            for (int r = 4; r < 16; r += 4) { ma = MX3(ma, p0[r], p0[r + 1]); mb = MX3(mb, p0[r + 2], p0[r + 3]); ma = MX3(ma, p1[r], p1[r + 1]); mb = MX3(mb, p1[r + 2], p1[r + 3]); }
#undef MX3
            float rm = fmaxf(ma, mb); rm = fmaxf(rm, __shfl_xor(rm, 32));
            if (__any(rm > 8.0f)) {
                const float dl = fmaxf(rm, 0.f), f = __builtin_amdgcn_exp2f(-dl);
                cm -= dl; lrun *= f; if (FOX) { A_WAVE_BOUND(); }
#pragma unroll
                for (int r = 0; r < 16; ++r) { p0[r] -= dl; p1[r] -= dl; o0[r] *= f; o1[r] *= f; }
            }
            f32x2 s2 = (f32x2){0.f, 0.f};
#pragma unroll
            for (int r = 0; r < 16; r += 2) { p0[r] = __builtin_amdgcn_exp2f(p0[r]); p0[r + 1] = __builtin_amdgcn_exp2f(p0[r + 1]); p1[r] = __builtin_amdgcn_exp2f(p1[r]); p1[r + 1] = __builtin_amdgcn_exp2f(p1[r + 1]);
                s2 += (f32x2){p0[r], p0[r + 1]}; s2 += (f32x2){p1[r], p1[r + 1]}; }
            lrun += s2.x + s2.y;
            u32x4 pw[4];
            pw[0] = (u32x4){pk2(p0[0], p0[1]), pk2(p0[2], p0[3]), pk2(p0[4], p0[5]), pk2(p0[6], p0[7])};
            pw[1] = (u32x4){pk2(p0[8], p0[9]), pk2(p0[10], p0[11]), pk2(p0[12], p0[13]), pk2(p0[14], p0[15])};
            pw[2] = (u32x4){pk2(p1[0], p1[1]), pk2(p1[2], p1[3]), pk2(p1[4], p1[5]), pk2(p1[6], p1[7])};
            pw[3] = (u32x4){pk2(p1[8], p1[9]), pk2(p1[10], p1[11]), pk2(p1[12], p1[13]), pk2(p1[14], p1[15])};
            const LAS unsigned char* vb = lds + A_VOFF + b * A_VB + r32 * A_VROW + hi * 8;
#pragma unroll
            for (int ks = 0; ks < 4; ++ks) {
                const s16x4 l0 = *(const LAS s16x4*)(vb + ks * 32), h0 = *(const LAS s16x4*)(vb + ks * 32 + 16);
                const s16x4 l1 = *(const LAS s16x4*)(vb + 32 * A_VROW + ks * 32), h1 = *(const LAS s16x4*)(vb + 32 * A_VROW + ks * 32 + 16);
                const bf16x8 va = (bf16x8){l0[0], l0[1], l0[2], l0[3], h0[0], h0[1], h0[2], h0[3]};
                const bf16x8 vbb = (bf16x8){l1[0], l1[1], l1[2], l1[3], h1[0], h1[1], h1[2], h1[3]};
                const bf16x8 pf = __builtin_bit_cast(bf16x8, pw[ks]);
                o0 = __builtin_amdgcn_mfma_f32_32x32x16_bf16(va, pf, o0, 0, 0, 0);
                o1 = __builtin_amdgcn_mfma_f32_32x32x16_bf16(vbb, pf, o1, 0, 0, 0);
            }
        }
        if (it + 1 < NT) A_WRITE_STAGE(b ^ 1);
        if (FOX && t >= 1 && lane == 0) *(LAS float*)(lds + A_COFF + 512 + b * 32 + wid * 4) = wb - LDG(float, clk + (t - 1) * 64 + 63);
        __syncthreads();
        if (FOX && t >= 1) {
            const f32x4 b0 = *(const LAS f32x4*)(lds + A_COFF + 512 + b * 32), b1 = *(const LAS f32x4*)(lds + A_COFF + 512 + b * 32 + 16);
            const float bm = fmaxf(fmaxf(fmaxf(b0[0], b0[1]), fmaxf(b0[2], b0[3])), fmaxf(fmaxf(b1[0], b1[1]), fmaxf(b1[2], b1[3])));
            if (bm < -160.0f) break;
        }
        kreg = kreg2; vreg = vreg2; creg = creg2;
    }
#undef A_LOAD_TILE
#undef A_WAVE_BOUND
#undef A_WRITE_STAGE
    lrun += __shfl_xor(lrun, 32);
    const float inv = 1.0f / lrun;
    bf16* orow = Op + (size_t)(wid * 32 + r32) * opitch + 4 * hi;
#pragma unroll
    for (int g = 0; g < 4; ++g) {
        u32x2 w0, w1;
        w0.x = pk2(o0[4 * g] * inv, o0[4 * g + 1] * inv); w0.y = pk2(o0[4 * g + 2] * inv, o0[4 * g + 3] * inv);
        w1.x = pk2(o1[4 * g] * inv, o1[4 * g + 1] * inv); w1.y = pk2(o1[4 * g + 2] * inv, o1[4 * g + 3] * inv);
        STG(u32x2, orow + 8 * g, w0); STG(u32x2, orow + 32 + 8 * g, w1);
    }
}

constexpr int G_VST = 136;
__device__ __forceinline__ void gmlp_unit(LAS unsigned char* lds, const bf16* Z, const bf16* Wsb, const float* bs, const float* vg, bf16* MIX, int b, int c, int g, int tid, int lane, int wid) {
    const size_t row0 = (size_t)b * SEQ + (size_t)c * 128;
    const int r32 = lane & 31, hi = lane >> 5, tb = wid & 3, db = wid >> 2;
    const int s_ = tid >> 2, qd = tid & 3;
    const bf16* vp = Z + (row0 + s_) * ZP + 384 + g * 64 + qd * 16;
    const u32x4 w0 = LDG(u32x4, vp), w1 = LDG(u32x4, vp + 8);
    const int t = 32 * tb + r32;
    const bf16* up = Z + (row0 + t) * ZP + g * 64 + 32 * db + 4 * hi;
    u32x2 uw[4];
#pragma unroll
    for (int gi = 0; gi < 4; ++gi) uw[gi] = LDG(u32x2, up + 8 * gi);
    const float bias = LDG(float, bs + g * 128 + t);
    const bf16* wp = Wsb + (size_t)g * 128 * 128 + (size_t)t * 128 + hi * 8;
    bf16x8 wfr[8];
#pragma unroll
    for (int ks = 0; ks < 8; ++ks) wfr[ks] = LDG(bf16x8, wp + ks * 16);
    const float* gp = vg + g * 64 + qd * 16;
    f32x4 gq[4];
#pragma unroll
    for (int e = 0; e < 4; ++e) gq[e] = LDG(f32x4, gp + 4 * e);
    {
        float x[16];
        x[0] = bf_lo(w0.x); x[1] = bf_hi(w0.x); x[2] = bf_lo(w0.y); x[3] = bf_hi(w0.y); x[4] = bf_lo(w0.z); x[5] = bf_hi(w0.z); x[6] = bf_lo(w0.w); x[7] = bf_hi(w0.w);
        x[8] = bf_lo(w1.x); x[9] = bf_hi(w1.x); x[10] = bf_lo(w1.y); x[11] = bf_hi(w1.y); x[12] = bf_lo(w1.z); x[13] = bf_hi(w1.z); x[14] = bf_lo(w1.w); x[15] = bf_hi(w1.w);
        float ss = 0.f;
#pragma unroll
        for (int e = 0; e < 16; ++e) { x[e] = gelu_tanh(x[e]); ss += x[e] * x[e]; }
        ss += __shfl_xor(ss, 1); ss += __shfl_xor(ss, 2);
        const float rn = 1.0f / sqrtf(ss * (1.0f / 64.0f) + RMS_EPS);
        LAS unsigned short* vt = (LAS unsigned short*)(lds) + (qd * 16) * G_VST + s_;
#pragma unroll
        for (int e = 0; e < 16; e += 2) { const unsigned w = pk2(x[e] * rn * gq[e >> 2][e & 3], x[e + 1] * rn * gq[(e + 1) >> 2][(e + 1) & 3]); vt[e * G_VST] = (unsigned short)(w & 0xffffu); vt[(e + 1) * G_VST] = (unsigned short)(w >> 16); }
    }
    __syncthreads();
    f32x16 acc;
#pragma unroll
    for (int r = 0; r < 16; ++r) acc[r] = 0.f;
    const LAS unsigned char* va = lds + (size_t)(32 * db + r32) * (G_VST * 2) + hi * 16;
#pragma unroll
    for (int ks = 0; ks < 8; ++ks) {
        if (ks < 2 * tb + 2) {
            const s16x4 l0 = *(const LAS s16x4*)(va + ks * 32), h0 = *(const LAS s16x4*)(va + ks * 32 + 8);
            const bf16x8 af = (bf16x8){l0[0], l0[1], l0[2], l0[3], h0[0], h0[1], h0[2], h0[3]};
            acc = __builtin_amdgcn_mfma_f32_32x32x16_bf16(af, wfr[ks], acc, 0, 0, 0);
        }
    }
    {
        bf16* op = MIX + (row0 + t) * DM + g * 64 + 32 * db + 4 * hi;
#pragma unroll
        for (int gi = 0; gi < 4; ++gi) {
            const float u0 = gelu_tanh(bf_lo(uw[gi].x)), u1 = gelu_tanh(bf_hi(uw[gi].x)), u2 = gelu_tanh(bf_lo(uw[gi].y)), u3 = gelu_tanh(bf_hi(uw[gi].y));
            u32x2 w; w.x = pk2(u0 * (acc[4 * gi] + bias), u1 * (acc[4 * gi + 1] + bias)); w.y = pk2(u2 * (acc[4 * gi + 2] + bias), u3 * (acc[4 * gi + 3] + bias));
            STG(u32x2, op + 8 * gi, w);
        }
    }
    __syncthreads();
}

constexpr int N_FOX = BATCH * 6 * 16, N_MEMA = BATCH * 4 * 16, N_GMLP = BATCH * 32 * 6, N_MIXITEMS = N_FOX + N_MEMA + N_GMLP;
__device__ __forceinline__ void phase_mix(const Args& a, unsigned char* ws, int l, int rep, LAS unsigned char* lds, int tid0, int lane0, int wid0) {
    const bf16* Z = (const bf16*)(ws + WS_Z); bf16* MIX = (bf16*)(ws + WS_MIX);
    const float* CL = (const float*)(ws + WS_CL); const bf16* KVM = (const bf16*)(ws + WS_KVM);
    unsigned* counter = (unsigned*)(ws + WS_CTL) + 64 * l + 16 * rep;
    volatile LAS unsigned* slot = (volatile LAS unsigned*)(lds + 131072);
    unsigned nxt = 0u; if (tid0 == 0) nxt = atomicAdd(counter, 1u);
    for (;;) {
        int tid = tid0; asm volatile("" : "+v"(tid));
        const int lane = tid & 63, wid = __builtin_amdgcn_readfirstlane(tid >> 6);
        if (tid == 0) slot[0] = nxt;
        __syncthreads();
        const int idx = (int)slot[0];
        __syncthreads();
        if (idx >= N_MIXITEMS) break;
        if (tid == 0) nxt = atomicAdd(counter, 1u);
        if (idx < N_FOX) {
            const int qb = 15 - idx / 48, bh = idx % 48, b = bh / 6, h = bh % 6;
            const size_t r0 = (size_t)b * SEQ;
            attn_unit<true>(lds, Z + (r0 + qb * 256) * ZP + 768 + h * 64, ZP, Z + r0 * ZP + 1152 + h * 64, ZP, (const bf16*)(ws + WS_VT) + (size_t)bh * 64 * SEQ, SEQ,
                            CL + (size_t)bh * SEQ + qb * 256, CL + (size_t)bh * SEQ, MIX + (r0 + qb * 256) * DM + 384 + h * 64, DM, qb * 256, 4 * qb + 4, __uint_as_float(__hip_atomic_load((unsigned*)(ws + WS_CTL) + 512 + l * 64 + bh, __ATOMIC_RELAXED, __HIP_MEMORY_SCOPE_AGENT)), tid, lane, wid);
        } else if (idx < N_FOX + N_MEMA) {
            const int j = idx - N_FOX, bh = j % 32, qb = j / 32, b = bh / 4, h = bh % 4;
            const size_t r0 = (size_t)b * SEQ;
            attn_unit<false>(lds, Z + (r0 + qb * 256) * ZP + 1920 + h * 64, ZP, KVM + (size_t)b * NMEM * 1024 + l * 512 + h * 64, 1024, (const bf16*)(ws + WS_VMT) + (size_t)((l * 8 + b) * 4 + h) * 64 * 256, 256,
                             nullptr, nullptr, MIX + (r0 + qb * 256) * DM + 768 + h * 64, DM, 0, 4, 0.f, tid, lane, wid);
        } else {
            const int j = idx - N_FOX - N_MEMA, g = j % 6, bc = j / 6;
            gmlp_unit(lds, Z, (const bf16*)(ws + WS_WS) + (size_t)l * 6 * 128 * 128, a.in[11] + l * 6 * 128, a.in[9] + l * 384, MIX, bc / 32, bc % 32, g, tid, lane, wid);
        }
    }
}

#define GRID_SEAM() xcd_barrier(xbar)
constexpr int N_PHASES = 1 + 8 * DEPTH;
__global__ void __launch_bounds__(NTHREADS, 2) mk_fwd(Args a) {
    extern __shared__ __attribute__((aligned(16))) unsigned char lds_raw[];
    LAS unsigned char* lds = (LAS unsigned char*)lds_raw;
    const int G = gridDim.x;
    if (threadIdx.x < 2) ((LAS unsigned*)(lds + 131072 + 64))[threadIdx.x] = 0u;
    __syncthreads();
    XcdBarrier xbar = xcd_barrier_post((unsigned*)(a.ws + WS_CTL) + 4096, (volatile LAS unsigned*)(lds + 131072 + 64));
#if !MK_PER_PHASE
    if (a.ph_lo < 0) cg::this_grid().sync();
#endif
#ifndef REPEAT_P
#define REPEAT_P -1
#endif
    int rep = 0;
    for (int p = a.ph_lo; p < a.ph_hi; ++p) {
        int tid = threadIdx.x; asm volatile("" : "+v"(tid));
        unsigned char* ws = a.ws; asm volatile("" : "+s"(ws));
        const int lane = tid & 63, wave = __builtin_amdgcn_readfirstlane(tid >> 6);
        bf16* XB = (bf16*)(ws + WS_XB); float* RSTD = (float*)(ws + WS_RSTD); bf16* Y = (bf16*)(ws + WS_Y);
        bool do_gemm = false; int cu = (int)blockIdx.x;
        pg8::Gemm g{nullptr, nullptr, 0, 0, 0}; pg8::EpiT E{0, nullptr, 0, nullptr, nullptr, nullptr, nullptr, nullptr};
        if (p == 0) phase_prep(a, ws, lds, tid, lane, wave);
        else {
            const int l = (p - 1) >> 3, s = (p - 1) & 7;
            if (s == 0) {
                g = pg8::Gemm{XB, (const bf16*)(ws + WS_WIN) + (size_t)l * NIN * DM, M, NIN, DM};
                E = pg8::EpiT{3, (bf16*)(ws + WS_Z), ZP, RSTD, (float*)(ws + WS_CL), a.in[8] + l * 6, (bf16*)(ws + WS_VT), (unsigned*)(ws + WS_CTL) + 512 + l * 64}; do_gemm = true;
            } else if (s == 1) {
                phase_cumsum((float*)(ws + WS_CL), lds, tid, lane, wave);
            } else if (s == 2) {
                phase_mix(a, ws, l, rep, lds, tid, lane, wave);
            } else if (s == 3) {
                g = pg8::Gemm{(const bf16*)(ws + WS_MIX), (const bf16*)(ws + WS_WOUT) + (size_t)l * DM * DM, M, DM, DM};
                E = pg8::EpiT{0, Y, DM, nullptr, nullptr, nullptr, nullptr, nullptr}; do_gemm = true;
            } else if (s == 4) {
                phase_rows<false, false>(nullptr, nullptr, Y, a.in[3] + l * DM, XB, RSTD, lane, wave);
            } else if (s == 5) {
                g = pg8::Gemm{XB, (const bf16*)(ws + WS_W1) + (size_t)l * DFF * DM, M, DFF, DM};
                E = pg8::EpiT{2, (bf16*)(ws + WS_HID), DFF, RSTD, nullptr, nullptr, nullptr}; do_gemm = true;
            } else if (s == 6) {
                g = pg8::Gemm{(const bf16*)(ws + WS_HID), (const bf16*)(ws + WS_W2) + (size_t)l * DM * DFF, M, DM, DFF};
                E = pg8::EpiT{0, Y, DM, nullptr, nullptr, nullptr, nullptr, nullptr}; do_gemm = true;
            } else {
                if (l == DEPTH - 1) phase_rows<false, true>(nullptr, a.out, Y, a.in[5] + l * DM, XB, RSTD, lane, wave); else phase_rows<false, false>(nullptr, nullptr, Y, a.in[5] + l * DM, XB, RSTD, lane, wave);
            }
        }
        if (do_gemm) {
            const int ngemm = (p == 1) ? 2 : 1;
            for (int gi = 0; gi < ngemm; ++gi) {
                if (gi == 1) {
                    g = pg8::Gemm{(const bf16*)(ws + WS_MEMB), (const bf16*)(ws + WS_WKV), MMEM, 1024, DM}; cu = (int)((blockIdx.x + G / 2) % G);
                    E = pg8::EpiT{1, (bf16*)(ws + WS_KVM), 1024, nullptr, nullptr, nullptr, (bf16*)(ws + WS_VMT), nullptr};
                }
                pg8::StaticOrder S; S.init(g.M, g.N, G, cu); pg8::gemm_phase<pg8::EpiT, pg8::StaticOrder, true, true>(lds, g, S, E);
            }
            if ((p == 1 || p == 9) && (int)blockIdx.x >= G / 2)
                run_transposes(a, ws, (LAS float*)(lds + wave * 16384), (p == 1) ? 1 : 2, (p == 1) ? NITEMS_B : NITEMS_C, ((int)blockIdx.x - G / 2) * NWAVES + wave, (G - G / 2) * NWAVES, lane);
        }
        if (p == REPEAT_P && rep == 0) { rep = 1; --p; GRID_SEAM(); continue; }
        rep = 0;
        if (p + 1 < a.ph_hi) { GRID_SEAM(); }
    }
#ifdef DBG_STOP
    { GRID_SEAM();
      unsigned char* ws = a.ws;
      for (size_t i = (size_t)blockIdx.x * NTHREADS + threadIdx.x; i < (size_t)M * DM; i += (size_t)gridDim.x * NTHREADS) {
#if DBG_F32
          a.out[i] = ((const float*)(ws + DBG_OFF))[i % DBG_N];
#elif defined(DBG_CLO)
          { const size_t row = i >> 10; const int col = (int)(i & 1023); a.out[i] = (col < 256) ? __uint_as_float((unsigned)((const bf16*)(ws + DBG_OFF))[row * DBG_PITCH + DBG_CLO + col] << 16) : 0.f; }
#else
          a.out[i] = __uint_as_float((unsigned)((const bf16*)(ws + DBG_OFF))[i % DBG_N] << 16);
#endif
      } }
#endif
}

extern "C" void kernel_launch(void* const* d_in, const int* in_sizes, int n_in, void* d_out, int out_size, void* d_ws, size_t ws_size, hipStream_t stream) {
    static int grid = 0;
    if (grid == 0) {
        if (n_in != 16 || out_size != M * DM || ws_size < WS_END) { fprintf(stderr, "kernel_launch: unexpected shapes (n_in %d out %d ws %zu)\n", n_in, out_size, ws_size); grid = -1; return; }
        int dev = 0, cus = 0, per_cu = 0;
        hipGetDevice(&dev);
        hipDeviceGetAttribute(&cus, hipDeviceAttributeMultiprocessorCount, dev);
        if (hipFuncSetAttribute((const void*)mk_fwd, hipFuncAttributeMaxDynamicSharedMemorySize, LDS_BYTES) != hipSuccess) { fprintf(stderr, "kernel_launch: hipFuncSetAttribute failed\n"); grid = -1; return; }
        if (hipOccupancyMaxActiveBlocksPerMultiprocessor(&per_cu, (const void*)mk_fwd, NTHREADS, LDS_BYTES) != hipSuccess || per_cu < 1) { fprintf(stderr, "kernel_launch: occupancy query says %d blocks/CU\n", per_cu); (void)hipGetLastError(); per_cu = 1; }
        grid = cus * 1;
        fprintf(stderr, "kernel_launch: cus %d per_cu %d grid %d\n", cus, per_cu, grid);
    }
    if (grid < 0) return;
    if (hipMemsetAsync((char*)d_ws + WS_CTL, 0, 65536, stream) != hipSuccess) { fprintf(stderr, "kernel_launch: hipMemsetAsync failed\n"); return; }
    Args a{};
    for (int i = 0; i < 16; ++i) a.in[i] = (const float*)d_in[i];
    a.out = (float*)d_out; a.ws = (unsigned char*)d_ws;
#if MK_PER_PHASE
    for (int p = 0; p < N_PHASES; ++p) { a.ph_lo = p; a.ph_hi = p + 1; hipLaunchKernelGGL(mk_fwd, dim3(grid), dim3(NTHREADS), LDS_BYTES, stream, a); }
#else
    a.ph_lo = 0; a.ph_hi = N_PHASES;
#ifdef DBG_STOP
    a.ph_hi = DBG_STOP;
#endif
    void* args[] = {&a};
    hipError_t e = hipLaunchCooperativeKernel((const void*)mk_fwd, dim3(grid), dim3(NTHREADS), args, LDS_BYTES, stream);
    if (e != hipSuccess) fprintf(stderr, "kernel_launch: cooperative launch failed: %s (grid %d)\n", hipGetErrorString(e), grid);
#endif
}
```

```cpp
#include <hip/hip_runtime.h>
#include <hip/hip_cooperative_groups.h>
#include <cstdio>
#include <cstdint>
namespace cg = cooperative_groups;
#ifndef MK_PER_PHASE
#define MK_PER_PHASE 0
#endif
namespace pg8 {
#define PG8_LAS __attribute__((address_space(3)))
typedef unsigned short bf16_t;
typedef short bf16x8 __attribute__((ext_vector_type(8)));
typedef float f32x4 __attribute__((ext_vector_type(4)));
typedef unsigned u32x4 __attribute__((ext_vector_type(4)));
constexpr int BM = 256, BK = 64, HALF = 128, HTB = HALF * BK * 2  , STAGE_BYTES = 8 * HTB, NXCD = 8, WGM = 8;

__host__ __device__ __forceinline__ int lds_byte(int r, int c) { const int st = (r >> 4) * 2 + (c >> 5), rr = r & 15, cc = c & 31, ob = rr * 64 + cc * 2; return st * 1024 + (ob ^ (((ob >> 9) & 1) << 5)); }
__host__ __device__ __forceinline__ void stage_rc(int b, int& R, int& C) { const int st = b / 1024, sb = b % 1024, swz = sb ^ (((sb >> 9) & 1) << 5); R = (st >> 1) * 16 + swz / 64; C = (st & 1) * 32 + (swz % 64) / 2; }
__host__ __device__ __forceinline__ int perm32(int rho) { const int n = rho >> 4, i = rho & 15; return 8 * (i >> 2) + 4 * n + (i & 3); }

struct Unit { int pm, pn; };
struct Gemm { const bf16_t* A; const bf16_t* Bt; int M, N, K; };

struct StaticOrder {
    int nM, nN, nwg, G, c;
    __host__ __device__ void init(int M, int N, int G_, int c_) { nM = M / BM; nN = N / BM; nwg = nM * nN; G = G_; c = c_; }
    __host__ __device__ bool next(int i, Unit& u) const {
        const long L = (long)i * G + c; if (L >= nwg) return false;
        int wgid = (int)L; { const int q = nwg / NXCD, r = nwg % NXCD, xcd = wgid % NXCD, off = wgid / NXCD; wgid = (xcd < r ? xcd * (q + 1) : r * (q + 1) + (xcd - r) * q) + off; }
        const int nig = WGM * nN, gid = wgid / nig, fm = gid * WGM, gsz = (nM - fm) < WGM ? (nM - fm) : WGM;
        u.pm = fm + ((wgid % nig) % gsz); u.pn = (wgid % nig) / gsz; return true;
    }
    __device__ __forceinline__ void a_ready(const Unit&) const {}
    __device__ __forceinline__ void done(const Unit&) const {}
};

typedef float f32x2_cv __attribute__((ext_vector_type(2))); typedef __bf16 bf16x2_cv __attribute__((ext_vector_type(2)));
__device__ __forceinline__ unsigned cvt_pk_bf16(float lo, float hi) { const f32x2_cv v = {lo, hi}; const bf16x2_cv b = __builtin_convertvector(v, bf16x2_cv); return __builtin_bit_cast(unsigned, b); }
constexpr float QC2 = 0.125f * 1.4426950408889634f;
struct EpiT {
    static constexpr bool PERM = true, AFTER_DRAIN = false;
    int MODE; bf16_t* O; int ldc; const float* rs; float* logf; const float* bfg; bf16_t* vt; unsigned* kinf;
    __device__ __forceinline__ void operator()(const f32x4 (&acc)[2][2][4][2], const Unit& u, int wr, int wc, int fr, int fq) const {
        const int row0 = u.pm * BM + wr * 64 + fr;
        const int cb = u.pn * BM + wc * 32 + 8 * fq;
        float kmx0 = 0.f, kmx1 = 0.f;
#pragma unroll
        for (int ai = 0; ai < 2; ++ai)
#pragma unroll
            for (int m = 0; m < 4; ++m) {
                const int row = row0 + ai * HALF + m * 16;
#pragma unroll
                for (int bj = 0; bj < 2; ++bj) {
                    const int c0 = cb + bj * HALF;
                    f32x4 v0 = acc[ai][bj][m][0], v1 = acc[ai][bj][m][1];
                    if (MODE == 2) {
#pragma unroll
                        for (int e = 0; e < 4; ++e) { const float a = fmaxf(v0[e], 0.f), b = fmaxf(v1[e], 0.f); v0[e] = a * a; v1[e] = b * b; }
                    }
                    if (MODE == 3) {
                        if (c0 >= 2176) {
                            if (c0 == 2176) {
                                const int bb = row >> 12, ss = row & 4095;
#define GATE_ST(h, val) do { const float y = (val) + bfg[h]; const float lf = fminf(y, 0.f) - log1pf(__expf(-fabsf(y))); logf[(size_t)(bb * 6 + (h)) * 4096 + ss] = lf; } while (0)
                                GATE_ST(0, v0[0]); GATE_ST(1, v0[1]); GATE_ST(2, v0[2]); GATE_ST(3, v0[3]); GATE_ST(4, v1[0]); GATE_ST(5, v1[1]);
#undef GATE_ST
                            }
                            continue;
                        }
                        const float sc = ((c0 >= 768 && c0 < 1152) || c0 >= 1920) ? QC2 : 1.f;
                        if (c0 >= 1152 && c0 < 1536) {
                            float mm = fmaxf(fmaxf(fabsf(v0[0]), fabsf(v0[1])), fmaxf(fabsf(v0[2]), fabsf(v0[3]))); mm = fmaxf(mm, fmaxf(fmaxf(fabsf(v1[0]), fabsf(v1[1])), fmaxf(fabsf(v1[2]), fabsf(v1[3]))));
                            if (bj == 0) kmx0 = fmaxf(kmx0, mm); else kmx1 = fmaxf(kmx1, mm);
                        }
                        v0 = v0 * sc; v1 = v1 * sc;
                    }
                    u32x4 w; w.x = cvt_pk_bf16(v0[0], v0[1]); w.y = cvt_pk_bf16(v0[2], v0[3]); w.z = cvt_pk_bf16(v1[0], v1[1]); w.w = cvt_pk_bf16(v1[2], v1[3]);
                    if (MODE == 3 && c0 >= 1536 && c0 < 1920) {
                        const int hh = (c0 - 1536) >> 6, d0 = (c0 - 1536) & 63;
                        bf16_t* vp = vt + ((size_t)((row >> 12) * 6 + hh) * 64 + d0) * 4096 + (row & 4095);
                        vp[0 * 4096] = (bf16_t)(w.x & 0xffffu); vp[1 * 4096] = (bf16_t)(w.x >> 16); vp[2 * 4096] = (bf16_t)(w.y & 0xffffu); vp[3 * 4096] = (bf16_t)(w.y >> 16);
                        vp[4 * 4096] = (bf16_t)(w.z & 0xffffu); vp[5 * 4096] = (bf16_t)(w.z >> 16); vp[6 * 4096] = (bf16_t)(w.w & 0xffffu); vp[7 * 4096] = (bf16_t)(w.w >> 16);
                        continue;
                    }
                    if (MODE == 1 && (c0 & 511) >= 256) {
                        const int ll = c0 >> 9, hd = (c0 & 511) - 256, hh = hd >> 6, d0 = hd & 63;
                        bf16_t* vp = vt + ((size_t)(((ll * 8 + (row >> 8)) * 4 + hh) * 64 + d0)) * 256 + (row & 255);
#define VM_ST(e, val) asm volatile("global_store_short %0, %1, off sc0 sc1" :: "v"(vp + (e) * 256), "v"(val) : "memory")
                        VM_ST(0, w.x & 0xffffu); VM_ST(1, w.x >> 16); VM_ST(2, w.y & 0xffffu); VM_ST(3, w.y >> 16); VM_ST(4, w.z & 0xffffu); VM_ST(5, w.z >> 16); VM_ST(6, w.w & 0xffffu); VM_ST(7, w.w >> 16);
#undef VM_ST
                        continue;
                    }
                    if (MODE == 1) { asm volatile("global_store_dwordx4 %0, %1, off sc0 sc1" :: "v"(O + (size_t)row * ldc + c0), "v"(w) : "memory"); }
                    else *(u32x4*)(O + (size_t)row * ldc + c0) = w;
                }
            }
        if (MODE == 3) {
#pragma unroll
            for (int bj = 0; bj < 2; ++bj) {
                const int c0 = cb + bj * HALF;
                if (c0 >= 1152 && c0 < 1536) {
                    float mm = bj == 0 ? kmx0 : kmx1;
#pragma unroll
                    for (int o = 1; o < 64; o <<= 1) mm = fmaxf(mm, __shfl_xor(mm, o));
                    if ((fr | fq) == 0) atomicMax(kinf + ((row0 >> 12) * 6 + ((c0 - 1152) >> 6)), __float_as_uint(mm));
                }
            }
        }
    }
};
template <class Epi, class Sched, bool ALIGN_EPI = false, bool SP2 = false>
__device__ __forceinline__ void gemm_phase(PG8_LAS unsigned char* lds, const Gemm g, const Sched& S, const Epi& E) {
    int tid = threadIdx.x; asm volatile("" : "+v"(tid));
    const int wid = __builtin_amdgcn_readfirstlane(tid >> 6), lane = tid & 63, wr = wid >> 2, wc = wid & 3, fr = lane & 15, fq = lane >> 4;
    const int K = g.K, nt = K / BK;
    unsigned voffA[2], voffB[2];
#pragma unroll
    for (int i = 0; i < 2; ++i) { int R, C; stage_rc(tid * 16 + i * 8192, R, C); const int Rb = Epi::PERM ? ((R & ~31) + perm32(R & 31)) : R;
        voffA[i] = (unsigned)(R * K + C) * 2u; voffB[i] = (unsigned)(Rb * K + C) * 2u; }
    const size_t kstep = (size_t)(BK * 2);
    const size_t hstep = (size_t)HALF * K * 2;
    const size_t tstep = 2 * hstep;
    const unsigned ldsw = (unsigned)wid * 1024u;
    const int aoff = lds_byte(wr * 64 + fr, fq * 8), boff = lds_byte(wc * 32 + fr, fq * 8);
#define PG8_SA(b, h) (((b) * 2 + (h)) * HTB)
#define PG8_SB(b, h) ((4 + (b) * 2 + (h)) * HTB)
#define PG8_STAGE(bufoff, gbase, voff) do { _Pragma("unroll") for (int _i = 0; _i < 2; ++_i) \
        __builtin_amdgcn_global_load_lds((const unsigned*)((const char*)(gbase) + (voff)[_i]), (PG8_LAS unsigned*)(lds + (bufoff) + ldsw + _i * 8192), 16, 0, 0); } while (0)
#define PG8_LDA(dst, b, h) do { _Pragma("unroll") for (int m = 0; m < 4; ++m) _Pragma("unroll") for (int k = 0; k < 2; ++k) dst[m][k] = *(const PG8_LAS bf16x8*)(lds + PG8_SA(b, h) + aoff + m * 2048 + k * 1024); } while (0)
#define PG8_LDB(dst, b, h) do { _Pragma("unroll") for (int n = 0; n < 2; ++n) _Pragma("unroll") for (int k = 0; k < 2; ++k) dst[n][k] = *(const PG8_LAS bf16x8*)(lds + PG8_SB(b, h) + boff + n * 2048 + k * 1024); } while (0)
#define PG8_MMA(ai, bj, At, Bt) do { __builtin_amdgcn_s_setprio(1); _Pragma("unroll") for (int m = 0; m < 4; ++m) _Pragma("unroll") for (int n = 0; n < 2; ++n) _Pragma("unroll") for (int k = 0; k < 2; ++k) \
        acc[ai][bj][m][n] = __builtin_amdgcn_mfma_f32_16x16x32_bf16(Bt[n][k], At[m][k], acc[ai][bj][m][n], 0, 0, 0); __builtin_amdgcn_s_setprio(0); } while (0)
#define PG8_WAIT_V(n) asm volatile("s_waitcnt vmcnt(" #n ")" ::: "memory")
#define PG8_WAIT_L(n) asm volatile("s_waitcnt lgkmcnt(" #n ")" ::: "memory")
#define PG8_BAR __builtin_amdgcn_s_barrier()
#define PG8_SCHED __builtin_amdgcn_sched_barrier(0)
    Unit cur, nxt; int ui = 0;
    if (!S.next(0, cur)) return;
    f32x4 acc[2][2][4][2];
#pragma unroll
    for (int a = 0; a < 2; ++a)
#pragma unroll
        for (int b = 0; b < 2; ++b)
#pragma unroll
            for (int m = 0; m < 4; ++m)
#pragma unroll
                for (int n = 0; n < 2; ++n) acc[a][b][m][n] = (f32x4){0.f, 0.f, 0.f, 0.f};
    bf16x8 At[4][2], B0[2][2], B1[2][2];
    const char* cA = (const char*)g.A + (size_t)cur.pm * tstep; const char* cB = (const char*)g.Bt + (size_t)cur.pn * tstep;
    S.a_ready(cur);
    if constexpr (SP2) {
        PG8_STAGE(PG8_SB(0, 0), cB, voffB); PG8_STAGE(PG8_SB(0, 1), cB + hstep, voffB); PG8_STAGE(PG8_SA(0, 0), cA, voffA); PG8_STAGE(PG8_SA(0, 1), cA + hstep, voffA);
        if (wr == 1) PG8_BAR;
        PG8_WAIT_V(2); PG8_BAR;
        PG8_STAGE(PG8_SB(1, 0), cB + kstep, voffB); PG8_STAGE(PG8_SA(1, 0), cA + kstep, voffA); PG8_STAGE(PG8_SB(1, 1), cB + hstep + kstep, voffB);
        PG8_WAIT_V(6); PG8_BAR;
    } else {
        PG8_STAGE(PG8_SB(0, 0), cB, voffB); PG8_STAGE(PG8_SA(0, 0), cA, voffA); PG8_STAGE(PG8_SB(0, 1), cB + hstep, voffB); PG8_STAGE(PG8_SA(0, 1), cA + hstep, voffA);
        if (wr == 1) PG8_BAR;
        PG8_WAIT_V(4); PG8_BAR;
        PG8_STAGE(PG8_SB(1, 0), cB + kstep, voffB); PG8_STAGE(PG8_SA(1, 0), cA + kstep, voffA); PG8_STAGE(PG8_SB(1, 1), cB + hstep + kstep, voffB);
        PG8_WAIT_V(6); PG8_BAR;
    }
    for (;;) {
        const bool has_next = S.next(ui + 1, nxt);
        const char* nA = has_next ? (const char*)g.A + (size_t)nxt.pm * tstep : cA; const char* nB = has_next ? (const char*)g.Bt + (size_t)nxt.pn * tstep : cB;
        for (int t = 0; t < nt; t += 2) {
            const bool last = (t == nt - 2);
            const char* a1 = cA + (size_t)(t + 1) * kstep;
            const char* a2 = last ? nA : cA + (size_t)(t + 2) * kstep; const char* b2 = last ? nB : cB + (size_t)(t + 2) * kstep;
            const char* a3 = a2 + kstep; const char* b3 = b2 + kstep;
            if (last && has_next) S.a_ready(nxt);
            if constexpr (SP2) {
            PG8_LDB(B0, 0, 0); PG8_LDB(B1, 0, 1); PG8_SCHED; PG8_LDA(At, 0, 0); PG8_STAGE(PG8_SA(1, 1), a1 + hstep, voffA);
            PG8_WAIT_V(8); PG8_WAIT_L(0); PG8_BAR; PG8_MMA(0, 0, At, B0); PG8_MMA(0, 1, At, B1); PG8_BAR; PG8_SCHED;
            PG8_LDA(At, 0, 1); PG8_STAGE(PG8_SB(0, 0), b2, voffB); PG8_STAGE(PG8_SB(0, 1), b2 + hstep, voffB); PG8_STAGE(PG8_SA(0, 0), a2, voffA);
            PG8_WAIT_V(8); PG8_WAIT_L(0); PG8_BAR; PG8_MMA(1, 0, At, B0); PG8_MMA(1, 1, At, B1); PG8_BAR; PG8_SCHED;
            PG8_LDB(B0, 1, 0); PG8_LDB(B1, 1, 1); PG8_SCHED; PG8_LDA(At, 1, 0); PG8_STAGE(PG8_SA(0, 1), a2 + hstep, voffA);
            PG8_WAIT_V(8); PG8_WAIT_L(0); PG8_BAR; PG8_MMA(0, 0, At, B0); PG8_MMA(0, 1, At, B1); PG8_BAR; PG8_SCHED;
            PG8_LDA(At, 1, 1); PG8_STAGE(PG8_SB(1, 0), b3, voffB); PG8_STAGE(PG8_SB(1, 1), b3 + hstep, voffB); PG8_STAGE(PG8_SA(1, 0), a3, voffA);
            PG8_WAIT_V(8); PG8_WAIT_L(0); PG8_BAR; PG8_MMA(1, 0, At, B0); PG8_MMA(1, 1, At, B1); PG8_BAR; PG8_SCHED;
            } else {
            PG8_LDB(B0, 0, 0); PG8_SCHED; PG8_LDA(At, 0, 0); PG8_STAGE(PG8_SA(1, 1), a1 + hstep, voffA);
            PG8_WAIT_L(8); PG8_BAR; PG8_WAIT_L(0); PG8_MMA(0, 0, At, B0); PG8_BAR; PG8_SCHED;
            PG8_LDB(B1, 0, 1); PG8_STAGE(PG8_SB(0, 0), b2, voffB);
            PG8_BAR; PG8_WAIT_L(0); PG8_MMA(0, 1, At, B1); PG8_BAR;
            PG8_LDA(At, 0, 1); PG8_STAGE(PG8_SA(0, 0), a2, voffA);
            PG8_BAR; PG8_WAIT_L(0); PG8_MMA(1, 0, At, B0); PG8_BAR; PG8_SCHED;
            PG8_STAGE(PG8_SB(0, 1), b2 + hstep, voffB);
            PG8_WAIT_V(6); PG8_BAR; PG8_MMA(1, 1, At, B1); PG8_BAR;
            PG8_LDB(B0, 1, 0); PG8_SCHED; PG8_LDA(At, 1, 0); PG8_STAGE(PG8_SA(0, 1), a2 + hstep, voffA);
            PG8_WAIT_L(8); PG8_BAR; PG8_WAIT_L(0); PG8_MMA(0, 0, At, B0); PG8_BAR; PG8_SCHED;
            PG8_LDB(B1, 1, 1); PG8_STAGE(PG8_SB(1, 0), b3, voffB);
            PG8_BAR; PG8_WAIT_L(0); PG8_MMA(0, 1, At, B1); PG8_BAR;
            PG8_LDA(At, 1, 1); PG8_STAGE(PG8_SA(1, 0), a3, voffA);
            PG8_BAR; PG8_WAIT_L(0); PG8_MMA(1, 0, At, B0); PG8_BAR; PG8_SCHED;
            PG8_STAGE(PG8_SB(1, 1), b3 + hstep, voffB);
            PG8_WAIT_V(6); PG8_BAR; PG8_MMA(1, 1, At, B1); PG8_BAR;
            }
        }
        if constexpr (ALIGN_EPI) { if (wr == 0) PG8_BAR; }
        if constexpr (!Epi::AFTER_DRAIN) { E(acc, cur, wr, wc, fr, fq); S.done(cur); }
        if (!has_next) break;
#pragma unroll
        for (int a = 0; a < 2; ++a)
#pragma unroll
            for (int b = 0; b < 2; ++b)
#pragma unroll
                for (int m = 0; m < 4; ++m)
#pragma unroll
                    for (int n = 0; n < 2; ++n) acc[a][b][m][n] = (f32x4){0.f, 0.f, 0.f, 0.f};
        cur = nxt; cA = nA; cB = nB; ++ui;
        if constexpr (ALIGN_EPI) { if (wr == 1) PG8_BAR; }
    }
    PG8_WAIT_V(0);
    if constexpr (!ALIGN_EPI) { if (wr == 0) PG8_BAR; }
    PG8_BAR;
    if constexpr (Epi::AFTER_DRAIN) { E.fused(acc, cur, wr, wc, fr, fq, lds, wid, lane); S.done(cur); }
#undef PG8_SA
#undef PG8_SB
#undef PG8_STAGE
#undef PG8_LDA
#undef PG8_LDB
#undef PG8_MMA
#undef PG8_WAIT_V
#undef PG8_WAIT_L
#undef PG8_BAR
#undef PG8_SCHED
}
}
constexpr int NWAVES = 8, NTHREADS = 512;
constexpr int BATCH = 8, SEQ = 4096, DM = 1024, DEPTH = 2, NMEM = 256, HD = 64;
constexpr int M = BATCH * SEQ;
constexpr int MMEM = BATCH * NMEM;
constexpr int D_IN = 2182, NIN = 2304;
constexpr int ZP = 2176;
constexpr int DFF = 4096;
constexpr float RMS_EPS = 1e-6f;
constexpr float LOG2E = 1.4426950408889634f;

constexpr size_t MiB = 1u << 20;
constexpr size_t WS_CTL = 0;
constexpr size_t WS_WIN = 1 * MiB;
constexpr size_t WS_WOUT = 10 * MiB;
constexpr size_t WS_W1 = 14 * MiB;
constexpr size_t WS_W2 = 30 * MiB;
constexpr size_t WS_WKV = 46 * MiB;
constexpr size_t WS_WS = 48 * MiB;
constexpr size_t WS_RSTD = 49 * MiB;
constexpr size_t WS_CL = 50 * MiB;
constexpr size_t WS_MEMB = 52 * MiB;
constexpr size_t WS_KVM = 56 * MiB;
constexpr size_t WS_XB = 64 * MiB;
constexpr size_t WS_Y = 128 * MiB;
constexpr size_t WS_HID = 192 * MiB;
constexpr size_t WS_Z = 192 * MiB;
constexpr size_t WS_MIX = 328 * MiB;
constexpr size_t WS_VT = 392 * MiB;
constexpr size_t WS_VMT = 60 * MiB;
constexpr size_t WS_END = 448 * MiB;

constexpr int LDS_BYTES = 131072 + 1024;

#define GAS __attribute__((address_space(1)))
#define LAS __attribute__((address_space(3)))
typedef unsigned short bf16;
typedef unsigned u32x4 __attribute__((ext_vector_type(4)));
typedef unsigned u32x2 __attribute__((ext_vector_type(2)));
typedef float f32x4 __attribute__((ext_vector_type(4)));
typedef float f32x16 __attribute__((ext_vector_type(16)));
typedef float f32x2 __attribute__((ext_vector_type(2)));
typedef short bf16x8 __attribute__((ext_vector_type(8)));
typedef short s16x4 __attribute__((ext_vector_type(4)));

#define LDG(T, p) (*(const GAS T*)(p))
#define STG(T, p, v) (*(GAS T*)(p) = (v))
__device__ __forceinline__ unsigned pk2(float lo, float hi) { return pg8::cvt_pk_bf16(lo, hi); }
__device__ __forceinline__ float bf_lo(unsigned u) { return __uint_as_float(u << 16); }
__device__ __forceinline__ float bf_hi(unsigned u) { return __uint_as_float(u & 0xffff0000u); }
__device__ __forceinline__ float wave_sum(float v) {
#pragma unroll
    for (int o = 1; o < 64; o <<= 1) v += __shfl_xor(v, o);
    return v;
}
__device__ __forceinline__ float gelu_tanh(float x) {
    const float t = x + 0.044715f * x * x * x;
    const float e = __builtin_amdgcn_exp2f(-2.3022082f * t);
    return x * __builtin_amdgcn_rcpf(1.0f + e);
}
__device__ __forceinline__ int crow(int r, int hi) { return (r & 3) + 8 * (r >> 2) + 4 * hi; }

#define XB_TMO      128
#define XB_XCNT(j)  (256  + 64 * (j))
#define XB_XSUB(j)  (1280 + 64 * (j))
#define XB_XGEN(j)  (2304 + 64 * (j))
#define XB_TOP      3328
#define XB_TOPGEN   3392
#define XCD_BAR_WORDS 3456
#define XB_SPIN_CAP (1u << 18)

__device__ __forceinline__ unsigned xb_ld(unsigned* p)              { return __hip_atomic_load(p, __ATOMIC_RELAXED, __HIP_MEMORY_SCOPE_AGENT); }
__device__ __forceinline__ unsigned xb_add(unsigned* p, unsigned v) { return __hip_atomic_fetch_add(p, v, __ATOMIC_RELAXED, __HIP_MEMORY_SCOPE_AGENT); }
__device__ __forceinline__ unsigned xb_xcc_id() { return (unsigned)__builtin_amdgcn_s_getreg((3 << 11) | 20) & 0xFu; }
#define XB_SPIN(cond, bar) do { unsigned _sp = 0; while (cond) { __builtin_amdgcn_s_sleep(1); \
    if ((++_sp & 255u) == 0u) { if (xb_ld(&(bar)[XB_TMO])) break; if (_sp > XB_SPIN_CAP) { atomicAdd(&(bar)[XB_TMO], 1u); break; } } } } while (0)

struct XcdBarrier {
    unsigned* bar; unsigned x;
    volatile LAS unsigned* st;
};

__device__ __forceinline__ XcdBarrier xcd_barrier_post(unsigned* bar, volatile LAS unsigned* st) {
    XcdBarrier b; b.bar = bar; b.x = xb_xcc_id(); b.st = st;
    if (threadIdx.x == 0) (void)xb_add(&bar[XB_XCNT(b.x)], 1u);
    return b;
}
__device__ __forceinline__ void xcd_barrier_complete(unsigned* bar, unsigned x, unsigned& nloc, unsigned& nx) {
    const unsigned G = gridDim.x * gridDim.y * gridDim.z;
    unsigned sum, cnt, mine, sp = 0u;
    for (;;) {
        sum = 0u; cnt = 0u; mine = 0u;
#pragma unroll
        for (unsigned j = 0; j < 16; ++j) { const unsigned c = xb_ld(&bar[XB_XCNT(j)]); sum += c; cnt += (c > 0u) ? 1u : 0u; mine = (j == x) ? c : mine; }
        if (sum == G) break;
        __builtin_amdgcn_s_sleep(1);
        if ((++sp & 255u) == 0u) { if (xb_ld(&bar[XB_TMO])) break; if (sp > XB_SPIN_CAP) { atomicAdd(&bar[XB_TMO], 1u); break; } }
    }
    nloc = mine > 0u ? mine : 1u; nx = cnt > 0u ? cnt : 1u;
}

__device__ __forceinline__ void xcd_barrier(const XcdBarrier& b) {
    asm volatile("s_waitcnt vmcnt(0)" ::: "memory");
    __syncthreads();
    if (threadIdx.x == 0) {
        unsigned* bar = b.bar;
        __builtin_amdgcn_s_waitcnt(0);
        unsigned nloc = b.st[0], nx = b.st[1];
        if (nloc == 0u) { xcd_barrier_complete(bar, b.x, nloc, nx); b.st[0] = nloc; b.st[1] = nx; }
        const unsigned old = xb_add(&bar[XB_XSUB(b.x)], 1u);
        const unsigned gen = old / nloc;
        if (old + 1u == (gen + 1u) * nloc) {
            __builtin_amdgcn_fence(__ATOMIC_RELEASE, "agent");
            asm volatile("s_waitcnt vmcnt(0)" ::: "memory");
            const unsigned og = xb_add(&bar[XB_TOP], 1u);
            const unsigned tg = og / nx;
            if (og + 1u == (tg + 1u) * nx) xb_add(&bar[XB_TOPGEN], 1u);
            else XB_SPIN(xb_ld(&bar[XB_TOPGEN]) == tg, bar);
            __builtin_amdgcn_fence(__ATOMIC_ACQUIRE, "agent");
            xb_add(&bar[XB_XGEN(b.x)], 1u);
            asm volatile("s_waitcnt vmcnt(0)" ::: "memory");
        } else {
            XB_SPIN(xb_ld(&bar[XB_XGEN(b.x)]) == gen, bar);
            __builtin_amdgcn_fence(__ATOMIC_ACQUIRE, "agent");
            asm volatile("s_waitcnt vmcnt(0)" ::: "memory");
        }
    }
    __syncthreads();
}

struct Args {
    const float* in[16];
    float* out; unsigned char* ws;
    int ph_lo, ph_hi;
};

struct TItem { const float* W; int K, N, nblk; bf16* WT; const float* gain; int mode, item; };
__device__ __forceinline__ TItem prep_mat(const Args& a, unsigned char* ws, int l, int which, int r) {
    if (which == 0) return TItem{a.in[7] + (size_t)l * DM * D_IN, DM, D_IN, 72, (bf16*)(ws + WS_WIN) + (size_t)l * NIN * DM, a.in[2] + l * DM, 1, r};
    if (which == 1) return TItem{a.in[13] + (size_t)l * DM * DM, DM, DM, 32, (bf16*)(ws + WS_WOUT) + (size_t)l * DM * DM, nullptr, 0, r};
    if (which == 2) return TItem{a.in[14] + (size_t)l * DM * DFF, DM, DFF, 128, (bf16*)(ws + WS_W1) + (size_t)l * DFF * DM, a.in[4] + l * DM, 0, r};
    if (which == 3) return TItem{a.in[15] + (size_t)l * DFF * DM, DFF, DM, 32, (bf16*)(ws + WS_W2) + (size_t)l * DM * DFF, nullptr, 0, r};
    return TItem{a.in[12] + (size_t)l * DM * 512, DM, 512, 16, (bf16*)(ws + WS_WKV) + (size_t)l * 512 * DM, a.in[6] + l * DM, 0, r};
}
constexpr int I_IN = 16 * 72, I_OUT = 16 * 32, I_1 = 16 * 128, I_2 = 64 * 32, I_KV = 16 * 16;
constexpr int NITEMS_A = I_IN + 2 * I_KV;
constexpr int NITEMS_B = (I_OUT + I_1 + I_2) + I_IN;
constexpr int NITEMS_C = (I_OUT + I_1 + I_2);
__device__ __forceinline__ TItem prep_item(const Args& a, unsigned char* ws, int set, int j) {
    if (set == 0) { if (j < I_IN) return prep_mat(a, ws, 0, 0, j); j -= I_IN; if (j < I_KV) return prep_mat(a, ws, 0, 4, j); return prep_mat(a, ws, 1, 4, j - I_KV); }
    const int l = (set == 1) ? 0 : 1;
    if (j < I_OUT) return prep_mat(a, ws, l, 1, j); j -= I_OUT;
    if (j < I_1) return prep_mat(a, ws, l, 2, j); j -= I_1;
    if (j < I_2) return prep_mat(a, ws, l, 3, j); j -= I_2;
    return prep_mat(a, ws, 1, 0, j);
}
#define TITEM_LOAD(T, R) do { const int kb_ = (T).item / (T).nblk, nb_ = (T).item % (T).nblk, k0_ = 64 * kb_, n_ = 32 * nb_ + (lane & 31); int src_ = n_; float vm_ = 1.f; \
        if ((T).mode == 1) { src_ = (n_ < 1920) ? n_ : (n_ < 2176) ? n_ + 6 : (n_ < 2182) ? n_ - 256 : 0; vm_ = (n_ < 2182) ? 1.f : 0.f; } \
        const float* wp_ = (T).W + (size_t)(k0_ + (lane >> 5)) * (T).N + src_; const size_t rs_ = (size_t)2 * (T).N; \
        _Pragma("unroll") for (int i_ = 0; i_ < 32; ++i_) R[i_] = LDG(float, wp_ + i_ * rs_); \
        if ((T).mode == 1) { _Pragma("unroll") for (int i_ = 0; i_ < 32; ++i_) R[i_] *= vm_; } } while (0)
#define TITEM_FINISH(T, R) do { const int kb_ = (T).item / (T).nblk, nb_ = (T).item % (T).nblk, k0_ = 64 * kb_, n0_ = 32 * nb_; const int c_ = lane & 7; \
        f32x4 g0_ = (f32x4){1.f, 1.f, 1.f, 1.f}, g1_ = g0_; if ((T).gain) { g0_ = LDG(f32x4, (T).gain + k0_ + 8 * c_); g1_ = LDG(f32x4, (T).gain + k0_ + 8 * c_ + 4); } \
        _Pragma("unroll") for (int i_ = 0; i_ < 32; ++i_) scr[(2 * i_ + (lane >> 5)) * 33 + (lane & 31)] = R[i_]; \
        asm volatile("s_waitcnt lgkmcnt(0)" ::: "memory"); \
        _Pragma("unroll") for (int j_ = 0; j_ < 4; ++j_) { const int nn_ = (lane >> 3) + 8 * j_; const LAS float* s_ = scr + (8 * c_) * 33 + nn_; \
            u32x4 o_; o_.x = pk2(s_[0 * 33] * g0_[0], s_[1 * 33] * g0_[1]); o_.y = pk2(s_[2 * 33] * g0_[2], s_[3 * 33] * g0_[3]); o_.z = pk2(s_[4 * 33] * g1_[0], s_[5 * 33] * g1_[1]); o_.w = pk2(s_[6 * 33] * g1_[2], s_[7 * 33] * g1_[3]); \
            STG(u32x4, (T).WT + (size_t)(n0_ + nn_) * (T).K + k0_ + 8 * c_, o_); } \
        asm volatile("s_waitcnt lgkmcnt(0)" ::: "memory"); } while (0)
__device__ __forceinline__ void run_transposes(const Args& a, unsigned char* ws, LAS float* scr, int set, int nitems, int w, int nw, int lane) {
    float r[32], rn[32]; int it = w;
    if (it < nitems) { const TItem T = prep_item(a, ws, set, it); TITEM_LOAD(T, r); }
    for (; it < nitems; it += nw) {
        const int itn = it + nw;
        if (itn < nitems) { const TItem Tn = prep_item(a, ws, set, itn); TITEM_LOAD(Tn, rn); }
        const TItem T = prep_item(a, ws, set, it);
        TITEM_FINISH(T, r);
#pragma unroll
        for (int i = 0; i < 32; ++i) r[i] = rn[i];
    }
}
__device__ __forceinline__ void phase_prep(const Args& a, unsigned char* ws, LAS unsigned char* lds, int tid, int lane, int wave) {
    const int G = gridDim.x, gw = blockIdx.x * NWAVES + wave, NGW = G * NWAVES;
    if (blockIdx.x == 0 && tid < 256) ((unsigned*)(ws + WS_CTL))[tid] = 0u;
    LAS float* scr = (LAS float*)(lds + wave * 16384);
    {
        f32x4 v[4], vn[4]; int m = gw;
#define PREP_ROWPTR(mm) ((mm) < M ? a.in[0] + (size_t)(mm) * DM : a.in[1] + (size_t)((mm) - M) * DM)
        if (m < M + MMEM) { const f32x4* xr = (const f32x4*)PREP_ROWPTR(m) + lane;
#pragma unroll
            for (int j = 0; j < 4; ++j) v[j] = LDG(f32x4, xr + 64 * j); }
        for (; m < M + MMEM; m += NGW) {
            const int mn = m + NGW;
            if (mn < M + MMEM) { const f32x4* xr = (const f32x4*)PREP_ROWPTR(mn) + lane;
#pragma unroll
                for (int j = 0; j < 4; ++j) vn[j] = LDG(f32x4, xr + 64 * j); }
            float s = 0.f;
#pragma unroll
            for (int j = 0; j < 4; ++j) s += (v[j].x * v[j].x + v[j].y * v[j].y) + (v[j].z * v[j].z + v[j].w * v[j].w);
            const float ms = wave_sum(s) * (1.0f / 1024.0f) + RMS_EPS, rn = 1.0f / sqrtf(ms);
            if (m < M && lane == 0) STG(float, (float*)(ws + WS_RSTD) + m, sqrtf(ms));
            u32x2* o8 = (u32x2*)(m < M ? (bf16*)(ws + WS_XB) + (size_t)m * DM : (bf16*)(ws + WS_MEMB) + (size_t)(m - M) * DM) + lane;
#pragma unroll
            for (int j = 0; j < 4; ++j) { u32x2 w; w.x = pk2(v[j].x * rn, v[j].y * rn); w.y = pk2(v[j].z * rn, v[j].w * rn); STG(u32x2, o8 + 64 * j, w); }
#pragma unroll
            for (int j = 0; j < 4; ++j) v[j] = vn[j];
        }
#undef PREP_ROWPTR
    }
    run_transposes(a, ws, scr, 0, NITEMS_A, gw, NGW, lane);
    { const float* wsrc = a.in[10]; bf16* wd = (bf16*)(ws + WS_WS);
      for (int i = blockIdx.x * NTHREADS + tid; i < DEPTH * 6 * 128 * 128; i += G * NTHREADS) { const int s = i & 127, t = (i >> 7) & 127; const float v = (s <= t) ? wsrc[i] : 0.f; wd[i] = (bf16)(pk2(v, 0.f) & 0xffffu); } }
}
#undef TITEM_LOAD
#undef TITEM_FINISH

template <bool SRC_F32, bool DST_F32>
__device__ __forceinline__ void phase_rows(const float* XF, float* OF, const bf16* Y, const float* g, bf16* XB, float* RINV, int lane, int wave) {
    const int gw = blockIdx.x * NWAVES + wave, NGW = gridDim.x * NWAVES;
    f32x4 gv[4];
#pragma unroll
    for (int j = 0; j < 4; ++j) gv[j] = LDG(f32x4, (const f32x4*)g + lane + 64 * j);
    u32x2 yw[4], ywn[4], xw[4], xwn[4]; f32x4 xv[4], xvn[4]; float ri = 1.f, rin = 1.f;
    int m = gw;
#define ROWS_LOAD(mm, YW, XV, XW, RI) do { _Pragma("unroll") for (int j = 0; j < 4; ++j) { YW[j] = LDG(u32x2, (const u32x2*)(Y + (size_t)(mm) * DM) + lane + 64 * j); \
        if (SRC_F32) XV[j] = LDG(f32x4, (const f32x4*)(XF + (size_t)(mm) * DM) + lane + 64 * j); else XW[j] = LDG(u32x2, (const u32x2*)(XB + (size_t)(mm) * DM) + lane + 64 * j); } \
        if (!SRC_F32) RI = LDG(float, RINV + (mm)); } while (0)
    if (m < M) ROWS_LOAD(m, yw, xv, xw, ri);
    for (; m < M; m += NGW) {
        const int mn = m + NGW;
        if (mn < M) ROWS_LOAD(mn, ywn, xvn, xwn, rin);
        f32x4 yv[4]; float s = 0.f;
#pragma unroll
        for (int j = 0; j < 4; ++j) { const u32x2 w = yw[j]; yv[j] = (f32x4){bf_lo(w.x), bf_hi(w.x), bf_lo(w.y), bf_hi(w.y)};
            s += (yv[j].x * yv[j].x + yv[j].y * yv[j].y) + (yv[j].z * yv[j].z + yv[j].w * yv[j].w);
            if (!SRC_F32) { const u32x2 xx = xw[j]; xv[j] = (f32x4){bf_lo(xx.x), bf_hi(xx.x), bf_lo(xx.y), bf_hi(xx.y)} * ri; } }
        const float ry = 1.0f / sqrtf(wave_sum(s) * (1.0f / 1024.0f) + RMS_EPS);
        f32x4 xn[4]; float s2 = 0.f;
#pragma unroll
        for (int j = 0; j < 4; ++j) { xn[j] = xv[j] + yv[j] * ry * gv[j]; s2 += (xn[j].x * xn[j].x + xn[j].y * xn[j].y) + (xn[j].z * xn[j].z + xn[j].w * xn[j].w); }
        if (DST_F32) {
            f32x4* xo = (f32x4*)(OF + (size_t)m * DM) + lane;
#pragma unroll
            for (int j = 0; j < 4; ++j) STG(f32x4, xo + 64 * j, xn[j]);
        } else {
            const float ms = wave_sum(s2) * (1.0f / 1024.0f) + RMS_EPS, rn = 1.0f / sqrtf(ms);
            u32x2* bo = (u32x2*)(XB + (size_t)m * DM) + lane;
#pragma unroll
            for (int j = 0; j < 4; ++j) { u32x2 w; w.x = pk2(xn[j].x * rn, xn[j].y * rn); w.y = pk2(xn[j].z * rn, xn[j].w * rn); STG(u32x2, bo + 64 * j, w); }
            if (lane == 0) STG(float, RINV + m, sqrtf(ms));
        }
#pragma unroll
        for (int j = 0; j < 4; ++j) { yw[j] = ywn[j]; xv[j] = xvn[j]; xw[j] = xwn[j]; }
        ri = rin;
    }
#undef ROWS_LOAD
}

__device__ __forceinline__ void phase_cumsum(float* cl, LAS unsigned char* lds, int tid, int lane, int wave) {
    LAS float* wsum = (LAS float*)(lds);
    for (int bh = blockIdx.x; bh < BATCH * 6; bh += gridDim.x) {
        float* p = cl + (size_t)bh * SEQ + tid * 8;
        f32x4 a = ((const f32x4*)p)[0], b = ((const f32x4*)p)[1];
        a.y += a.x; a.z += a.y; a.w += a.z; b.x += a.w; b.y += b.x; b.z += b.y; b.w += b.z;
        const float tot = b.w; float sc = tot;
#pragma unroll
        for (int o = 1; o < 64; o <<= 1) { const float t = __shfl_up(sc, o); if (lane >= o) sc += t; }
        if (lane == 63) wsum[wave] = sc;
        __syncthreads();
        float off = sc - tot;
        for (int w = 0; w < wave; ++w) off += wsum[w];
        a = (a + off) * LOG2E; b = (b + off) * LOG2E;
        ((f32x4*)p)[0] = a; ((f32x4*)p)[1] = b;
        __syncthreads();
    }
}
constexpr int A_KB = 64 * 144, A_VOFF = 2 * A_KB, A_VROW = 136, A_VB = 64 * A_VROW, A_COFF = A_VOFF + 2 * A_VB;
constexpr float NEG_BIG = -1e30f;
__device__ __forceinline__ u32x4 ld16_coh(const void* p) { GAS unsigned* q = (GAS unsigned*)p; u32x4 r;
    r.x = __hip_atomic_load(q + 0, __ATOMIC_RELAXED, __HIP_MEMORY_SCOPE_AGENT); r.y = __hip_atomic_load(q + 1, __ATOMIC_RELAXED, __HIP_MEMORY_SCOPE_AGENT);
    r.z = __hip_atomic_load(q + 2, __ATOMIC_RELAXED, __HIP_MEMORY_SCOPE_AGENT); r.w = __hip_atomic_load(q + 3, __ATOMIC_RELAXED, __HIP_MEMORY_SCOPE_AGENT); return r; }
template <bool FOX>
__device__ __forceinline__ void attn_unit(LAS unsigned char* lds, const bf16* Qp, int qpitch, const bf16* Kp, int kvpitch, const bf16* Vp, int vpitch,
                                          const float* clq, const float* clk, bf16* Op, int opitch, int q0, int NT, float kinf, int tid, int lane, int wid) {
    const int r32 = lane & 31, hi = lane >> 5;
    bf16x8 qr[4];
    { const bf16* qrow = Qp + (size_t)(wid * 32 + r32) * qpitch + hi * 8;
#pragma unroll
      for (int ds = 0; ds < 4; ++ds) qr[ds] = LDG(bf16x8, qrow + ds * 16); }
    float clq_l = 0.f; if (FOX) clq_l = LDG(float, clq + wid * 32 + r32);
    const int skv = tid >> 3, sdc = tid & 7;
    const bf16* kg = Kp + (size_t)skv * kvpitch + sdc * 8;
    const bf16* vg = Vp + (size_t)skv * vpitch + sdc * 8;
    u32x4 kreg, vreg, kreg2, vreg2; float creg = 0.f, creg2 = 0.f;
#define A_LOAD_TILE(tt, KR, VR, CR) do { const size_t off_ = (size_t)(tt) * 64 * kvpitch; const int voff_ = (tt) * 64; \
        if (FOX) { KR = LDG(u32x4, kg + off_); VR = LDG(u32x4, vg + voff_); if (tid < 64) CR = LDG(float, clk + (tt) * 64 + tid); } else { KR = ld16_coh(kg + off_); VR = ld16_coh(vg + voff_); } } while (0)
    A_LOAD_TILE(NT - 1, kreg, vreg, creg);
#define A_WRITE_STAGE(b) do { \
        *(LAS u32x4*)(lds + (b) * A_KB + skv * 144 + sdc * 16) = kreg; \
        *(LAS u32x2*)(lds + A_VOFF + (b) * A_VB + skv * A_VROW + sdc * 16) = (u32x2){vreg.x, vreg.y}; *(LAS u32x2*)(lds + A_VOFF + (b) * A_VB + skv * A_VROW + sdc * 16 + 8) = (u32x2){vreg.z, vreg.w}; \
        if (FOX && tid < 64) *(LAS float*)(lds + A_COFF + (b) * 256 + tid * 4) = -creg; } while (0)
    A_WRITE_STAGE(0);
    if (NT > 1) A_LOAD_TILE(NT - 2, kreg, vreg, creg);
    __syncthreads();
    float qb = 0.f, wb = 0.f;
    if (FOX) {
        float l1 = 0.f;
#pragma unroll
        for (int ds = 0; ds < 4; ++ds)
#pragma unroll
            for (int e = 0; e < 8; ++e) l1 += fabsf(__uint_as_float((unsigned)(unsigned short)qr[ds][e] << 16));
        l1 += __shfl_xor(l1, 32);
        qb = l1 * kinf * 1.02f;
    }
    float cm = clq_l, lrun = 0.f; f32x16 o0, o1;
#pragma unroll
    for (int r = 0; r < 16; ++r) { o0[r] = 0.f; o1[r] = 0.f; }
    const int qmin_w = q0 + wid * 32, qmax_w = qmin_w + 31, qme = qmin_w + r32;
#define A_WAVE_BOUND() do { float t_ = qb + cm; _Pragma("unroll") for (int o_ = 1; o_ < 64; o_ <<= 1) t_ = fmaxf(t_, __shfl_xor(t_, o_)); wb = t_; } while (0)
    if (FOX) A_WAVE_BOUND();
    for (int it = 0; it < NT; ++it) {
        const int t = NT - 1 - it, b = it & 1;
        if (it + 2 < NT) A_LOAD_TILE(t - 2, kreg2, vreg2, creg2);
        const bool active = !FOX || (64 * t <= qmax_w);
        if (active) {
            f32x16 p0, p1;
            if (FOX) {
                const f32x2 cm2 = (f32x2){cm, cm};
#pragma unroll
                for (int g = 0; g < 4; ++g) {
                    const f32x4 c0 = *(const LAS f32x4*)(lds + A_COFF + b * 256 + (8 * g + 4 * hi) * 4);
                    const f32x4 c1 = *(const LAS f32x4*)(lds + A_COFF + b * 256 + (32 + 8 * g + 4 * hi) * 4);
                    const f32x2 a0 = cm2 + (f32x2){c0[0], c0[1]}, a1 = cm2 + (f32x2){c0[2], c0[3]}, b0 = cm2 + (f32x2){c1[0], c1[1]}, b1 = cm2 + (f32x2){c1[2], c1[3]};
                    p0[4 * g] = a0.x; p0[4 * g + 1] = a0.y; p0[4 * g + 2] = a1.x; p0[4 * g + 3] = a1.y;
                    p1[4 * g] = b0.x; p1[4 * g + 1] = b0.y; p1[4 * g + 2] = b1.x; p1[4 * g + 3] = b1.y;
                }
            } else {
#pragma unroll
                for (int r = 0; r < 16; ++r) { p0[r] = cm; p1[r] = cm; }
            }
            const LAS unsigned char* kb = lds + b * A_KB + r32 * 144 + hi * 16;
#pragma unroll
            for (int ds = 0; ds < 4; ++ds) {
                const bf16x8 a0 = *(const LAS bf16x8*)(kb + ds * 32);
                const bf16x8 a1 = *(const LAS bf16x8*)(kb + 32 * 144 + ds * 32);
                p0 = __builtin_amdgcn_mfma_f32_32x32x16_bf16(a0, qr[ds], p0, 0, 0, 0);
                p1 = __builtin_amdgcn_mfma_f32_32x32x16_bf16(a1, qr[ds], p1, 0, 0, 0);
            }
            if (FOX && (64 * t + 63 > qmin_w)) {
                const int kv0 = 64 * t + 4 * hi;
#pragma unroll
                for (int r = 0; r < 16; ++r) { const int kv = kv0 + (r & 3) + 8 * (r >> 2); if (kv > qme) p0[r] = NEG_BIG; if (kv + 32 > qme) p1[r] = NEG_BIG; }
            }
#define MX3(a, b, c) __builtin_fmaxf(__builtin_fmaxf((a), (b)), (c))
            float ma = MX3(p0[0], p0[1], p1[0]), mb = MX3(p0[2], p0[3], p1[1]); ma = MX3(ma, p1[2], p1[3]);
#pragma unroll
            for (int r = 4; r < 16; r += 4) { ma = MX3(ma, p0[r], p0[r + 1]); mb = MX3(mb, p0[r + 2], p0[r + 3]); ma = MX3(ma, p1[r], p1[r + 1]); mb = MX3(mb, p1[r + 2], p1[r + 3]); }
#undef MX3
            float rm = fmaxf(ma, mb); rm = fmaxf(rm, __shfl_xor(rm, 32));
            if (__any(rm > 8.0f)) {
                const float dl = fmaxf(rm, 0.f), f = __builtin_amdgcn_exp2f(-dl);
                cm -= dl; lrun *= f; if (FOX) { A_WAVE_BOUND(); }
#pragma unroll
                for (int r = 0; r < 16; ++r) { p0[r] -= dl; p1[r] -= dl; o0[r] *= f; o1[r] *= f; }
            }
            f32x2 s2 = (f32x2){0.f, 0.f};
#pragma unroll
            for (int r = 0; r < 16; r += 2) { p0[r] = __builtin_amdgcn_exp2f(p0[r]); p0[r + 1] = __builtin_amdgcn_exp2f(p0[r + 1]); p1[r] = __builtin_amdgcn_exp2f(p1[r]); p1[r + 1] = __builtin_amdgcn_exp2f(p1[r + 1]);
                s2 += (f32x2){p0[r], p0[r + 1]}; s2 += (f32x2){p1[r], p1[r + 1]}; }
            lrun += s2.x + s2.y;
            u32x4 pw[4];
            pw[0] = (u32x4){pk2(p0[0], p0[1]), pk2(p0[2], p0[3]), pk2(p0[4], p0[5]), pk2(p0[6], p0[7])};
            pw[1] = (u32x4){pk2(p0[8], p0[9]), pk2(p0[10], p0[11]), pk2(p0[12], p0[13]), pk2(p0[14], p0[15])};
            pw[2] = (u32x4){pk2(p1[0], p1[1]), pk2(p1[2], p1[3]), pk2(p1[4], p1[5]), pk2(p1[6], p1[7])};
            pw[3] = (u32x4){pk2(p1[8], p1[9]), pk2(p1[10], p1[11]), pk2(p1[12], p1[13]), pk2(p1[14], p1[15])};
            const LAS unsigned char* vb = lds + A_VOFF + b * A_VB + r32 * A_VROW + hi * 8;
#pragma unroll
            for (int ks = 0; ks < 4; ++ks) {
                const s16x4 l0 = *(const LAS s16x4*)(vb + ks * 32), h0 = *(const LAS s16x4*)(vb + ks * 32 + 16);
                const s16x4 l1 = *(const LAS s16x4*)(vb + 32 * A_VROW + ks * 32), h1 = *(const LAS s16x4*)(vb + 32 * A_VROW + ks * 32 + 16);
                const bf16x8 va = (bf16x8){l0[0], l0[1], l0[2], l0[3], h0[0], h0[1], h0[2], h0[3]};
                const bf16x8 vbb = (bf16x8){l1[0], l1[1], l1[2], l1[3], h1[0], h1[1], h1[2], h1[3]};
                const bf16x8 pf = __builtin_bit_cast(bf16x8, pw[ks]);
                o0 = __builtin_amdgcn_mfma_f32_32x32x16_bf16(va, pf, o0, 0, 0, 0);
                o1 = __builtin_amdgcn_mfma_f32_32x32x16_bf16(vbb, pf, o1, 0, 0, 0);
            }
        }
        if (it + 1 < NT) A_WRITE_STAGE(b ^ 1);
        if (FOX && t >= 1 && lane == 0) *(LAS float*)(lds + A_COFF + 512 + b * 32 + wid * 4) = wb - LDG(float, clk + (t - 1) * 64 + 63);
        __syncthreads();
        if (FOX && t >= 1) {
            const f32x4 b0 = *(const LAS f32x4*)(lds + A_COFF + 512 + b * 32), b1 = *(const LAS f32x4*)(lds + A_COFF + 512 + b * 32 + 16);
            const float bm = fmaxf(fmaxf(fmaxf(b0[0], b0[1]), fmaxf(b0[2], b0[3])), fmaxf(fmaxf(b1[0], b1[1]), fmaxf(b1[2], b1[3])));
            if (bm < -160.0f) break;
        }
        kreg = kreg2; vreg = vreg2; creg = creg2;
    }
#undef A_LOAD_TILE
#undef A_WAVE_BOUND
#undef A_WRITE_STAGE
    lrun += __shfl_xor(lrun, 32);
    const float inv = 1.0f / lrun;
    bf16* orow = Op + (size_t)(wid * 32 + r32) * opitch + 4 * hi;
#pragma unroll
    for (int g = 0; g < 4; ++g) {
        u32x2 w0, w1;
        w0.x = pk2(o0[4 * g] * inv, o0[4 * g + 1] * inv); w0.y = pk2(o0[4 * g + 2] * inv, o0[4 * g + 3] * inv);
        w1.x = pk2(o1[4 * g] * inv, o1[4 * g + 1] * inv); w1.y = pk2(o1[4 * g + 2] * inv, o1[4 * g + 3] * inv);
        STG(u32x2, orow + 8 * g, w0); STG(u32x2, orow + 32 + 8 * g, w1);
    }
}

constexpr int G_VST = 136;
__device__ __forceinline__ void gmlp_unit(LAS unsigned char* lds, const bf16* Z, const bf16* Wsb, const float* bs, const float* vg, bf16* MIX, int b, int c, int g, int tid, int lane, int wid) {
    const size_t row0 = (size_t)b * SEQ + (size_t)c * 128;
    const int r32 = lane & 31, hi = lane >> 5, tb = wid & 3, db = wid >> 2;
    const int s_ = tid >> 2, qd = tid & 3;
    const bf16* vp = Z + (row0 + s_) * ZP + 384 + g * 64 + qd * 16;
    const u32x4 w0 = LDG(u32x4, vp), w1 = LDG(u32x4, vp + 8);
    const int t = 32 * tb + r32;
    const bf16* up = Z + (row0 + t) * ZP + g * 64 + 32 * db + 4 * hi;
    u32x2 uw[4];
#pragma unroll
    for (int gi = 0; gi < 4; ++gi) uw[gi] = LDG(u32x2, up + 8 * gi);
    const float bias = LDG(float, bs + g * 128 + t);
    const bf16* wp = Wsb + (size_t)g * 128 * 128 + (size_t)t * 128 + hi * 8;
    bf16x8 wfr[8];
#pragma unroll
    for (int ks = 0; ks < 8; ++ks) wfr[ks] = LDG(bf16x8, wp + ks * 16);
    const float* gp = vg + g * 64 + qd * 16;
    f32x4 gq[4];
#pragma unroll
    for (int e = 0; e < 4; ++e) gq[e] = LDG(f32x4, gp + 4 * e);
    {
        float x[16];
        x[0] = bf_lo(w0.x); x[1] = bf_hi(w0.x); x[2] = bf_lo(w0.y); x[3] = bf_hi(w0.y); x[4] = bf_lo(w0.z); x[5] = bf_hi(w0.z); x[6] = bf_lo(w0.w); x[7] = bf_hi(w0.w);
        x[8] = bf_lo(w1.x); x[9] = bf_hi(w1.x); x[10] = bf_lo(w1.y); x[11] = bf_hi(w1.y); x[12] = bf_lo(w1.z); x[13] = bf_hi(w1.z); x[14] = bf_lo(w1.w); x[15] = bf_hi(w1.w);
        float ss = 0.f;
#pragma unroll
        for (int e = 0; e < 16; ++e) { x[e] = gelu_tanh(x[e]); ss += x[e] * x[e]; }
        ss += __shfl_xor(ss, 1); ss += __shfl_xor(ss, 2);
        const float rn = 1.0f / sqrtf(ss * (1.0f / 64.0f) + RMS_EPS);
        LAS unsigned short* vt = (LAS unsigned short*)(lds) + (qd * 16) * G_VST + s_;
#pragma unroll
        for (int e = 0; e < 16; e += 2) { const unsigned w = pk2(x[e] * rn * gq[e >> 2][e & 3], x[e + 1] * rn * gq[(e + 1) >> 2][(e + 1) & 3]); vt[e * G_VST] = (unsigned short)(w & 0xffffu); vt[(e + 1) * G_VST] = (unsigned short)(w >> 16); }
    }
    __syncthreads();
    f32x16 acc;
#pragma unroll
    for (int r = 0; r < 16; ++r) acc[r] = 0.f;
    const LAS unsigned char* va = lds + (size_t)(32 * db + r32) * (G_VST * 2) + hi * 16;
#pragma unroll
    for (int ks = 0; ks < 8; ++ks) {
        if (ks < 2 * tb + 2) {
            const s16x4 l0 = *(const LAS s16x4*)(va + ks * 32), h0 = *(const LAS s16x4*)(va + ks * 32 + 8);
            const bf16x8 af = (bf16x8){l0[0], l0[1], l0[2], l0[3], h0[0], h0[1], h0[2], h0[3]};
            acc = __builtin_amdgcn_mfma_f32_32x32x16_bf16(af, wfr[ks], acc, 0, 0, 0);
        }
    }
    {
        bf16* op = MIX + (row0 + t) * DM + g * 64 + 32 * db + 4 * hi;
#pragma unroll
        for (int gi = 0; gi < 4; ++gi) {
            const float u0 = gelu_tanh(bf_lo(uw[gi].x)), u1 = gelu_tanh(bf_hi(uw[gi].x)), u2 = gelu_tanh(bf_lo(uw[gi].y)), u3 = gelu_tanh(bf_hi(uw[gi].y));
            u32x2 w; w.x = pk2(u0 * (acc[4 * gi] + bias), u1 * (acc[4 * gi + 1] + bias)); w.y = pk2(u2 * (acc[4 * gi + 2] + bias), u3 * (acc[4 * gi + 3] + bias));
            STG(u32x2, op + 8 * gi, w);
        }
    }
    __syncthreads();
}

constexpr int N_FOX = BATCH * 6 * 16, N_MEMA = BATCH * 4 * 16, N_GMLP = BATCH * 32 * 6, N_MIXITEMS = N_FOX + N_MEMA + N_GMLP;
__device__ __forceinline__ void phase_mix(const Args& a, unsigned char* ws, int l, int rep, LAS unsigned char* lds, int tid0, int lane0, int wid0) {
    const bf16* Z = (const bf16*)(ws + WS_Z); bf16* MIX = (bf16*)(ws + WS_MIX);
    const float* CL = (const float*)(ws + WS_CL); const bf16* KVM = (const bf16*)(ws + WS_KVM);
    unsigned* counter = (unsigned*)(ws + WS_CTL) + 64 * l + 16 * rep;
    volatile LAS unsigned* slot = (volatile LAS unsigned*)(lds + 131072);
    unsigned nxt = 0u; if (tid0 == 0) nxt = atomicAdd(counter, 1u);
    for (;;) {
        int tid = tid0; asm volatile("" : "+v"(tid));
        const int lane = tid & 63, wid = __builtin_amdgcn_readfirstlane(tid >> 6);
        if (tid == 0) slot[0] = nxt;
        __syncthreads();
        const int idx = (int)slot[0];
        __syncthreads();
        if (idx >= N_MIXITEMS) break;
        if (tid == 0) nxt = atomicAdd(counter, 1u);
        if (idx < N_FOX) {
            const int qb = 15 - idx / 48, bh = idx % 48, b = bh / 6, h = bh % 6;
            const size_t r0 = (size_t)b * SEQ;
            attn_unit<true>(lds, Z + (r0 + qb * 256) * ZP + 768 + h * 64, ZP, Z + r0 * ZP + 1152 + h * 64, ZP, (const bf16*)(ws + WS_VT) + (size_t)bh * 64 * SEQ, SEQ,
                            CL + (size_t)bh * SEQ + qb * 256, CL + (size_t)bh * SEQ, MIX + (r0 + qb * 256) * DM + 384 + h * 64, DM, qb * 256, 4 * qb + 4, __uint_as_float(__hip_atomic_load((unsigned*)(ws + WS_CTL) + 512 + l * 64 + bh, __ATOMIC_RELAXED, __HIP_MEMORY_SCOPE_AGENT)), tid, lane, wid);
        } else if (idx < N_FOX + N_MEMA) {
            const int j = idx - N_FOX, bh = j % 32, qb = j / 32, b = bh / 4, h = bh % 4;
            const size_t r0 = (size_t)b * SEQ;
            attn_unit<false>(lds, Z + (r0 + qb * 256) * ZP + 1920 + h * 64, ZP, KVM + (size_t)b * NMEM * 1024 + l * 512 + h * 64, 1024, (const bf16*)(ws + WS_VMT) + (size_t)((l * 8 + b) * 4 + h) * 64 * 256, 256,
                             nullptr, nullptr, MIX + (r0 + qb * 256) * DM + 768 + h * 64, DM, 0, 4, 0.f, tid, lane, wid);
        } else {
            const int j = idx - N_FOX - N_MEMA, g = j % 6, bc = j / 6;
            gmlp_unit(lds, Z, (const bf16*)(ws + WS_WS) + (size_t)l * 6 * 128 * 128, a.in[11] + l * 6 * 128, a.in[9] + l * 384, MIX, bc / 32, bc % 32, g, tid, lane, wid);
        }
    }
}

#define GRID_SEAM() xcd_barrier(xbar)
constexpr int N_PHASES = 1 + 8 * DEPTH;
__global__ void __launch_bounds__(NTHREADS, 2) mk_fwd(Args a) {
    extern __shared__ __attribute__((aligned(16))) unsigned char lds_raw[];
    LAS unsigned char* lds = (LAS unsigned char*)lds_raw;
    const int G = gridDim.x;
    if (threadIdx.x < 2) ((LAS unsigned*)(lds + 131072 + 64))[threadIdx.x] = 0u;
    __syncthreads();
    XcdBarrier xbar = xcd_barrier_post((unsigned*)(a.ws + WS_CTL) + 4096, (volatile LAS unsigned*)(lds + 131072 + 64));
#if !MK_PER_PHASE
    if (a.ph_lo < 0) cg::this_grid().sync();
#endif
#ifndef REPEAT_P
#define REPEAT_P -1
#endif
    int rep = 0;
    for (int p = a.ph_lo; p < a.ph_hi; ++p) {
        int tid = threadIdx.x; asm volatile("" : "+v"(tid));
        unsigned char* ws = a.ws; asm volatile("" : "+s"(ws));
        const int lane = tid & 63, wave = __builtin_amdgcn_readfirstlane(tid >> 6);
        bf16* XB = (bf16*)(ws + WS_XB); float* RSTD = (float*)(ws + WS_RSTD); bf16* Y = (bf16*)(ws + WS_Y);
        bool do_gemm = false; int cu = (int)blockIdx.x;
        pg8::Gemm g{nullptr, nullptr, 0, 0, 0}; pg8::EpiT E{0, nullptr, 0, nullptr, nullptr, nullptr, nullptr, nullptr};
        if (p == 0) phase_prep(a, ws, lds, tid, lane, wave);
        else {
            const int l = (p - 1) >> 3, s = (p - 1) & 7;
            if (s == 0) {
                g = pg8::Gemm{XB, (const bf16*)(ws + WS_WIN) + (size_t)l * NIN * DM, M, NIN, DM};
                E = pg8::EpiT{3, (bf16*)(ws + WS_Z), ZP, RSTD, (float*)(ws + WS_CL), a.in[8] + l * 6, (bf16*)(ws + WS_VT), (unsigned*)(ws + WS_CTL) + 512 + l * 64}; do_gemm = true;
            } else if (s == 1) {
                phase_cumsum((float*)(ws + WS_CL), lds, tid, lane, wave);
            } else if (s == 2) {
                phase_mix(a, ws, l, rep, lds, tid, lane, wave);
            } else if (s == 3) {
                g = pg8::Gemm{(const bf16*)(ws + WS_MIX), (const bf16*)(ws + WS_WOUT) + (size_t)l * DM * DM, M, DM, DM};
                E = pg8::EpiT{0, Y, DM, nullptr, nullptr, nullptr, nullptr, nullptr}; do_gemm = true;
            } else if (s == 4) {
                phase_rows<false, false>(nullptr, nullptr, Y, a.in[3] + l * DM, XB, RSTD, lane, wave);
            } else if (s == 5) {
                g = pg8::Gemm{XB, (const bf16*)(ws + WS_W1) + (size_t)l * DFF * DM, M, DFF, DM};
                E = pg8::EpiT{2, (bf16*)(ws + WS_HID), DFF, RSTD, nullptr, nullptr, nullptr}; do_gemm = true;
            } else if (s == 6) {
                g = pg8::Gemm{(const bf16*)(ws + WS_HID), (const bf16*)(ws + WS_W2) + (size_t)l * DM * DFF, M, DM, DFF};
                E = pg8::EpiT{0, Y, DM, nullptr, nullptr, nullptr, nullptr, nullptr}; do_gemm = true;
            } else {
                if (l == DEPTH - 1) phase_rows<false, true>(nullptr, a.out, Y, a.in[5] + l * DM, XB, RSTD, lane, wave); else phase_rows<false, false>(nullptr, nullptr, Y, a.in[5] + l * DM, XB, RSTD, lane, wave);
            }
        }
        if (do_gemm) {
            const int ngemm = (p == 1) ? 2 : 1;
            for (int gi = 0; gi < ngemm; ++gi) {
                if (gi == 1) {
                    g = pg8::Gemm{(const bf16*)(ws + WS_MEMB), (const bf16*)(ws + WS_WKV), MMEM, 1024, DM}; cu = (int)((blockIdx.x + G / 2) % G);
                    E = pg8::EpiT{1, (bf16*)(ws + WS_KVM), 1024, nullptr, nullptr, nullptr, (bf16*)(ws + WS_VMT), nullptr};
                }
                pg8::StaticOrder S; S.init(g.M, g.N, G, cu); pg8::gemm_phase<pg8::EpiT, pg8::StaticOrder, true, true>(lds, g, S, E);
            }
            {
                const int first = (p == 1) ? G / 2 + 32 : G / 2;
                if ((p == 1 || p == 9) && first < G && (int)blockIdx.x >= first)
                    run_transposes(a, ws, (LAS float*)(lds + wave * 16384), (p == 1) ? 1 : 2, (p == 1) ? NITEMS_B : NITEMS_C, ((int)blockIdx.x - first) * NWAVES + wave, (G - first) * NWAVES, lane);
            }
        }
        if (p == REPEAT_P && rep == 0) { rep = 1; --p; GRID_SEAM(); continue; }
        rep = 0;
        if (p + 1 < a.ph_hi) { GRID_SEAM(); }
    }
#ifdef DBG_STOP
    { GRID_SEAM();
      unsigned char* ws = a.ws;
      for (size_t i = (size_t)blockIdx.x * NTHREADS + threadIdx.x; i < (size_t)M * DM; i += (size_t)gridDim.x * NTHREADS) {
#if DBG_F32
          a.out[i] = ((const float*)(ws + DBG_OFF))[i % DBG_N];
#elif defined(DBG_CLO)
          { const size_t row = i >> 10; const int col = (int)(i & 1023); a.out[i] = (col < 256) ? __uint_as_float((unsigned)((const bf16*)(ws + DBG_OFF))[row * DBG_PITCH + DBG_CLO + col] << 16) : 0.f; }
#else
          a.out[i] = __uint_as_float((unsigned)((const bf16*)(ws + DBG_OFF))[i % DBG_N] << 16);
#endif
      } }
#endif
}

extern "C" void kernel_launch(void* const* d_in, const int* in_sizes, int n_in, void* d_out, int out_size, void* d_ws, size_t ws_size, hipStream_t stream) {
    static int grid = 0;
    if (grid == 0) {
        if (n_in != 16 || out_size != M * DM || ws_size < WS_END) { fprintf(stderr, "kernel_launch: unexpected shapes (n_in %d out %d ws %zu)\n", n_in, out_size, ws_size); grid = -1; return; }
        int dev = 0, cus = 0, per_cu = 0;
        hipGetDevice(&dev);
        hipDeviceGetAttribute(&cus, hipDeviceAttributeMultiprocessorCount, dev);
        if (hipFuncSetAttribute((const void*)mk_fwd, hipFuncAttributeMaxDynamicSharedMemorySize, LDS_BYTES) != hipSuccess) { fprintf(stderr, "kernel_launch: hipFuncSetAttribute failed\n"); grid = -1; return; }
        if (hipOccupancyMaxActiveBlocksPerMultiprocessor(&per_cu, (const void*)mk_fwd, NTHREADS, LDS_BYTES) != hipSuccess || per_cu < 1) { fprintf(stderr, "kernel_launch: occupancy query says %d blocks/CU\n", per_cu); (void)hipGetLastError(); per_cu = 1; }
        grid = cus * 1;
        fprintf(stderr, "kernel_launch: cus %d per_cu %d grid %d\n", cus, per_cu, grid);
    }
    if (grid < 0) return;
    if (hipMemsetAsync((char*)d_ws + WS_CTL, 0, 65536, stream) != hipSuccess) { fprintf(stderr, "kernel_launch: hipMemsetAsync failed\n"); return; }
    Args a{};
    for (int i = 0; i < 16; ++i) a.in[i] = (const float*)d_in[i];
    a.out = (float*)d_out; a.ws = (unsigned char*)d_ws;
#if MK_PER_PHASE
    for (int p = 0; p < N_PHASES; ++p) { a.ph_lo = p; a.ph_hi = p + 1; hipLaunchKernelGGL(mk_fwd, dim3(grid), dim3(NTHREADS), LDS_BYTES, stream, a); }
#else
    a.ph_lo = 0; a.ph_hi = N_PHASES;
#ifdef DBG_STOP
    a.ph_hi = DBG_STOP;
#endif
    void* args[] = {&a};
    hipError_t e = hipLaunchCooperativeKernel((const void*)mk_fwd, dim3(grid), dim3(NTHREADS), args, LDS_BYTES, stream);
    if (e != hipSuccess) fprintf(stderr, "kernel_launch: cooperative launch failed: %s (grid %d)\n", hipGetErrorString(e), grid);
#endif
}
```
